# Optimizing an MI355X kernel written in HIP

```python
import math
import jax
import jax.numpy as jnp
from jax import lax
import numpy as np

D_MODEL = 1024
BATCH = 4
SEQ = 8192
DEPTH = 2

D_MIX = D_MODEL
GROUP_W = D_MIX // 4
HEAD_DIM = 64
GLA_HEADS = GROUP_W // HEAD_DIM
GLA_GATE_RANK = 16
GLA_GATE_NORMALIZER = 16.0
GLA_CHUNK = 64
FOX_HEADS = GROUP_W // HEAD_DIM
FOX_BLOCK = 128
SSM_HEADS = GROUP_W // HEAD_DIM
SSM_HEAD_DIM = HEAD_DIM
SSM_GROUPS = 2
SSM_STATE = 128
SSM_CONV = 4
SSM_CHUNK = 128
SSM_XBC = GROUP_W + 2 * SSM_GROUPS * SSM_STATE
SC_GROUPS = 4
SC_CONV = 3
D_FF = 2816
EPS = 1e-6

GLA_COLS = 4 * GROUP_W + GLA_GATE_RANK
FOX_COLS = 3 * GROUP_W + FOX_HEADS
SSM_COLS = GROUP_W + SSM_XBC + SSM_HEADS
SC_COLS = 3 * GROUP_W
IN_COLS = GLA_COLS + FOX_COLS + SSM_COLS + SC_COLS

kernel_name = 'hybrid_parallel_heads_gla_fox_ssd_shortconv'


def rms_norm(x, g):
    xf = x.astype(jnp.float32)
    y = xf * lax.rsqrt(jnp.mean(xf * xf, axis=-1, keepdims=True) + EPS)
    return (y * g.astype(jnp.float32)).astype(x.dtype)


def headwise_rms(x, g, n):
    shp = x.shape
    y = rms_norm(x.reshape(shp[:-1] + (shp[-1] // n, n)), g.reshape(-1, n))
    return y.reshape(shp)


def swiglu(h, w_gate, w_up, w_down):
    return (jax.nn.silu(h @ w_gate) * (h @ w_up)) @ w_down


def causal_depthwise_conv(u, w):
    K, C = w.shape
    return lax.conv_general_dilated(
        u, w[:, None, :].astype(u.dtype), window_strides=(1,),
        padding=[(K - 1, 0)], dimension_numbers=('NWC', 'WIO', 'NWC'),
        feature_group_count=C)


def gla_mixer(q, k, v, g_out, g_lr, w_gate_up, b_gate, norm_g):
    dtype = q.dtype
    f32 = jnp.float32
    Bsz, L, _ = q.shape
    H, D, C = GLA_HEADS, HEAD_DIM, GLA_CHUNK
    NC = L // C
    log_a = jax.nn.log_sigmoid((g_lr @ w_gate_up + b_gate).astype(f32)) / GLA_GATE_NORMALIZER

    def chunked(t):
        return t.astype(f32).reshape(Bsz, NC, C, H, D)

    qc = chunked(q) * (D ** -0.5)
    kc, vc, gc = chunked(k), chunked(v), chunked(log_a)
    b = jnp.cumsum(gc, axis=2)
    b_last = b[:, :, -1]
    q_dec = qc * jnp.exp(b)
    k_dec = kc * jnp.exp(-b)
    causal = jnp.tril(jnp.ones((C, C), bool))
    att = jnp.einsum('bnihd,bnjhd->bnhij', q_dec, k_dec)
    att = jnp.where(causal, att, 0.0)
    o_intra = jnp.einsum('bnhij,bnjhv->bnihv', att, vc)
    k_to_end = kc * jnp.exp(b_last[:, :, None] - b)
    chunk_kv = jnp.einsum('bnjhd,bnjhv->nbhdv', k_to_end, vc)
    chunk_decay = jnp.exp(b_last).transpose(1, 0, 2, 3)

    def step(S, inp):
        kv, dec = inp
        return S * dec[..., None] + kv, S

    S0 = jnp.zeros((Bsz, H, D, D), f32)
    _, S_prev = lax.scan(step, S0, (chunk_kv, chunk_decay))
    o_inter = jnp.einsum('bnihd,nbhdv->bnihv', q_dec, S_prev)
    o = (o_intra + o_inter).reshape(Bsz, L, H * D)
    o = headwise_rms(o, norm_g, D) * jax.nn.silu(g_out.astype(f32))
    return o.astype(dtype)


def fox_mixer(q, k, v, f_logit, b_forget, q_norm, k_norm, out_norm):
    dtype = q.dtype
    f32 = jnp.float32
    Bsz, L, _ = q.shape
    H, D, T = FOX_HEADS, HEAD_DIM, FOX_BLOCK
    NB = L // T
    qh = rms_norm(q.astype(f32).reshape(Bsz, L, H, D), q_norm) * (D ** -0.5)
    kh = rms_norm(k.astype(f32).reshape(Bsz, L, H, D), k_norm)
    vh = v.astype(f32).reshape(Bsz, L, H, D)
    log_f = jax.nn.log_sigmoid(f_logit.astype(f32) + b_forget.astype(f32))
    F = jnp.cumsum(log_f, axis=1)
    q_blocks = qh.reshape(Bsz, NB, T, H, D).transpose(1, 0, 2, 3, 4)
    F_blocks = F.reshape(Bsz, NB, T, H).transpose(1, 0, 2, 3)
    F_keys = F.transpose(0, 2, 1)[:, :, None, :]
    k_pos = jnp.arange(L)

    def block(args):
        qb, Fb, i = args
        s = jnp.einsum('bqhd,bkhd->bhqk', qb, kh)
        s = s + (Fb.transpose(0, 2, 1)[..., None] - F_keys)
        q_pos = i * T + jnp.arange(T)
        s = jnp.where(k_pos[None, :] <= q_pos[:, None], s, -jnp.inf)
        p = jax.nn.softmax(s, axis=-1)
        return jnp.einsum('bhqk,bkhd->bqhd', p, vh)

    o = lax.map(block, (q_blocks, F_blocks, jnp.arange(NB)))
    o = o.transpose(1, 0, 2, 3, 4).reshape(Bsz, L, H * D)
    return headwise_rms(o, out_norm, D).astype(dtype)


def ssd_mixer(z, xbc, dt_raw, conv_w, conv_b, dt_bias, A_log, D_skip, norm_g):
    dtype = z.dtype
    f32 = jnp.float32
    Bsz, L, _ = z.shape
    H, P, G, N, Q = SSM_HEADS, SSM_HEAD_DIM, SSM_GROUPS, SSM_STATE, SSM_CHUNK
    NC = L // Q
    xbc = jax.nn.silu(causal_depthwise_conv(xbc, conv_w) + conv_b).astype(f32)
    xs = xbc[..., :GROUP_W].reshape(Bsz, L, H, P)
    Bm = jnp.repeat(xbc[..., GROUP_W:GROUP_W + G * N].reshape(Bsz, L, G, N), H // G, axis=2)
    Cm = jnp.repeat(xbc[..., GROUP_W + G * N:].reshape(Bsz, L, G, N), H // G, axis=2)
    dt = jax.nn.softplus(dt_raw.astype(f32) + dt_bias.astype(f32))
    A = -jnp.exp(A_log.astype(f32))
    a = (dt * A).reshape(Bsz, NC, Q, H).transpose(0, 3, 1, 2)
    Xd = (xs * dt[..., None]).reshape(Bsz, NC, Q, H, P)
    Bc = Bm.reshape(Bsz, NC, Q, H, N)
    Cc = Cm.reshape(Bsz, NC, Q, H, N)
    a_cs = jnp.cumsum(a, axis=-1)
    causal = jnp.tril(jnp.ones((Q, Q), bool))
    seg = a_cs[..., :, None] - a_cs[..., None, :]
    Lmat = jnp.exp(jnp.where(causal, seg, -jnp.inf))
    scores = jnp.einsum('bcihn,bcjhn->bhcij', Cc, Bc) * Lmat
    y_diag = jnp.einsum('bhcij,bcjhp->bcihp', scores, Xd)
    decay_to_end = jnp.exp(a_cs[..., -1:] - a_cs)
    chunk_states = jnp.einsum('bcjhn,bhcj,bcjhp->cbhpn', Bc, decay_to_end, Xd)
    chunk_decay = jnp.exp(a_cs[..., -1]).transpose(2, 0, 1)

    def step(S, inp):
        st, dec = inp
        return S * dec[..., None, None] + st, S

    S0 = jnp.zeros((Bsz, H, P, N), f32)
    _, S_prev = lax.scan(step, S0, (chunk_states, chunk_decay))
    y_off = jnp.einsum('bcihn,cbhpn,bhci->bcihp', Cc, S_prev, jnp.exp(a_cs))
    y = (y_diag + y_off).reshape(Bsz, L, H, P) + xs * D_skip.astype(f32)[:, None]
    y = y.reshape(Bsz, L, H * P) * jax.nn.silu(z.astype(f32))
    return headwise_rms(y, norm_g, GROUP_W // G).astype(dtype)


def short_conv_mixer(b_gate, c_gate, val, conv_w, out_norm):
    y = b_gate * causal_depthwise_conv(c_gate * val, conv_w)
    return headwise_rms(y, out_norm, GROUP_W // SC_GROUPS)


def hybrid_mixing(h, w_in, gla_w_gate_up, gla_b_gate, gla_norm,
                  fox_b_forget, fox_q_norm, fox_k_norm, fox_out_norm,
                  ssm_conv_w, ssm_conv_b, ssm_dt_bias, ssm_A_log, ssm_D, ssm_norm,
                  sc_conv_w, sc_out_norm, w_out):
    proj = h @ w_in
    sizes = ([GROUP_W] * 4 + [GLA_GATE_RANK] + [GROUP_W] * 3 + [FOX_HEADS]
             + [GROUP_W, SSM_XBC, SSM_HEADS] + [GROUP_W] * 3)
    cuts = [int(c) for c in np.cumsum(sizes)[:-1]]
    (a_q, a_k, a_v, a_g, a_lr, b_q, b_k, b_v, b_f,
     c_z, c_xbc, c_dt, d_b, d_c, d_v) = jnp.split(proj, cuts, axis=-1)
    y_a = gla_mixer(a_q, a_k, a_v, a_g, a_lr, gla_w_gate_up, gla_b_gate, gla_norm)
    y_b = fox_mixer(b_q, b_k, b_v, b_f, fox_b_forget, fox_q_norm, fox_k_norm, fox_out_norm)
    y_c = ssd_mixer(c_z, c_xbc, c_dt, ssm_conv_w, ssm_conv_b, ssm_dt_bias, ssm_A_log, ssm_D, ssm_norm)
    y_d = short_conv_mixer(d_b, d_c, d_v, sc_conv_w, sc_out_norm)
    y = jnp.concatenate([y_a, y_b, y_c, y_d], axis=-1).astype(h.dtype)
    return y @ w_out


def setup_inputs(seed: int = 0) -> dict:
    key = jax.random.key(seed)
    k = jax.random.split(key, 27)
    f32 = jnp.float32
    Ld = DEPTH

    def nrm(kk, shape, scale):
        return jax.random.normal(kk, shape, f32) * scale

    def gain(kk, shape):
        return 1.0 + 0.02 * jax.random.normal(kk, shape, f32)

    dt0 = jnp.exp(jax.random.uniform(k[16], (Ld, SSM_HEADS), f32, math.log(1e-3), math.log(1e-1)))
    return {
        'x': nrm(k[0], (BATCH, SEQ, D_MODEL), 1.0),
        'ffn1_norm': gain(k[1], (Ld, D_MODEL)),
        'ffn1_w_gate': nrm(k[2], (Ld, D_MODEL, D_FF), D_MODEL ** -0.5),
        'ffn1_w_up': nrm(k[3], (Ld, D_MODEL, D_FF), D_MODEL ** -0.5),
        'ffn1_w_down': nrm(k[4], (Ld, D_FF, D_MODEL), D_FF ** -0.5),
        'mix_norm': gain(k[5], (Ld, D_MODEL)),
        'w_in': nrm(k[6], (Ld, D_MODEL, IN_COLS), D_MODEL ** -0.5),
        'gla_w_gate_up': nrm(k[7], (Ld, GLA_GATE_RANK, GROUP_W), GLA_GATE_RANK ** -0.5),
        'gla_b_gate': nrm(k[8], (Ld, GROUP_W), 0.1),
        'gla_norm': gain(k[9], (Ld, GROUP_W)),
        'fox_b_forget': 2.0 + nrm(k[10], (Ld, FOX_HEADS), 0.1),
        'fox_q_norm': gain(k[11], (Ld, HEAD_DIM)),
        'fox_k_norm': gain(k[12], (Ld, HEAD_DIM)),
        'fox_out_norm': gain(k[13], (Ld, GROUP_W)),
        'ssm_conv_w': nrm(k[14], (Ld, SSM_CONV, SSM_XBC), SSM_CONV ** -0.5),
        'ssm_conv_b': nrm(k[15], (Ld, SSM_XBC), 0.02),
        'ssm_dt_bias': dt0 + jnp.log(-jnp.expm1(-dt0)),
        'ssm_A_log': jnp.log(jax.random.uniform(k[17], (Ld, SSM_HEADS), f32, 1.0, 16.0)),
        'ssm_D': 1.0 + nrm(k[18], (Ld, SSM_HEADS), 0.1),
        'ssm_norm': gain(k[19], (Ld, GROUP_W)),
        'sc_conv_w': nrm(k[20], (Ld, SC_CONV, GROUP_W), SC_CONV ** -0.5),
        'sc_out_norm': gain(k[21], (Ld, GROUP_W)),
        'w_out': nrm(k[22], (Ld, D_MIX, D_MODEL), D_MIX ** -0.5),
        'ffn2_norm': gain(k[23], (Ld, D_MODEL)),
        'ffn2_w_gate': nrm(k[24], (Ld, D_MODEL, D_FF), D_MODEL ** -0.5),
        'ffn2_w_up': nrm(k[25], (Ld, D_MODEL, D_FF), D_MODEL ** -0.5),
        'ffn2_w_down': nrm(k[26], (Ld, D_FF, D_MODEL), D_FF ** -0.5),
    }


def reference(x, ffn1_norm, ffn1_w_gate, ffn1_w_up, ffn1_w_down,
              mix_norm, w_in, gla_w_gate_up, gla_b_gate, gla_norm,
              fox_b_forget, fox_q_norm, fox_k_norm, fox_out_norm,
              ssm_conv_w, ssm_conv_b, ssm_dt_bias, ssm_A_log, ssm_D, ssm_norm,
              sc_conv_w, sc_out_norm, w_out,
              ffn2_norm, ffn2_w_gate, ffn2_w_up, ffn2_w_down):
    for l in range(DEPTH):
        x = x + 0.5 * swiglu(rms_norm(x, ffn1_norm[l]), ffn1_w_gate[l], ffn1_w_up[l], ffn1_w_down[l])
        h = rms_norm(x, mix_norm[l])
        x = x + hybrid_mixing(h, w_in[l], gla_w_gate_up[l], gla_b_gate[l], gla_norm[l],
                              fox_b_forget[l], fox_q_norm[l], fox_k_norm[l], fox_out_norm[l],
                              ssm_conv_w[l], ssm_conv_b[l], ssm_dt_bias[l], ssm_A_log[l],
                              ssm_D[l], ssm_norm[l], sc_conv_w[l], sc_out_norm[l], w_out[l])
        x = x + 0.5 * swiglu(rms_norm(x, ffn2_norm[l]), ffn2_w_gate[l], ffn2_w_up[l], ffn2_w_down[l])
    return x
```

```cpp
#include <hip/hip_runtime.h>
#include <hip/hip_cooperative_groups.h>
#include <cstdio>
#include <cstdint>
namespace cg = cooperative_groups;
namespace pg8 {
#define PG8_LAS __attribute__((address_space(3)))
typedef unsigned short bf16_t;
typedef short bf16x8 __attribute__((ext_vector_type(8)));
typedef float f32x4 __attribute__((ext_vector_type(4)));
typedef unsigned u32x4 __attribute__((ext_vector_type(4)));
constexpr int BM = 256, BK = 64, HALF = 128, HTB = HALF * BK * 2  , STAGE_BYTES = 8 * HTB, NXCD = 8, WGM = 8;

__host__ __device__ __forceinline__ int lds_byte(int r, int c) { const int st = (r >> 4) * 2 + (c >> 5), rr = r & 15, cc = c & 31, ob = rr * 64 + cc * 2; return st * 1024 + (ob ^ (((ob >> 9) & 1) << 5)); }
__host__ __device__ __forceinline__ void stage_rc(int b, int& R, int& C) { const int st = b / 1024, sb = b % 1024, swz = sb ^ (((sb >> 9) & 1) << 5); R = (st >> 1) * 16 + swz / 64; C = (st & 1) * 32 + (swz % 64) / 2; }
__host__ __device__ __forceinline__ int perm32(int rho) { const int n = rho >> 4, i = rho & 15; return 8 * (i >> 2) + 4 * n + (i & 3); }

struct Unit { int pm, pn; };
struct Gemm { const bf16_t* A; const bf16_t* Bt; int M, N, K; };

struct StaticOrder {
    int nM, nN, nwg, G, c;
    __host__ __device__ void init(int M, int N, int G_, int c_) { nM = M / BM; nN = N / BM; nwg = nM * nN; G = G_; c = c_; }
    __host__ __device__ bool next(int i, Unit& u) const {
        const long L = (long)i * G + c; if (L >= nwg) return false;
        int wgid = (int)L; { const int q = nwg / NXCD, r = nwg % NXCD, xcd = wgid % NXCD, off = wgid / NXCD; wgid = (xcd < r ? xcd * (q + 1) : r * (q + 1) + (xcd - r) * q) + off; }
        const int nig = WGM * nN, gid = wgid / nig, fm = gid * WGM, gsz = (nM - fm) < WGM ? (nM - fm) : WGM;
        u.pm = fm + ((wgid % nig) % gsz); u.pn = (wgid % nig) / gsz; return true;
    }
    __device__ __forceinline__ void a_ready(const Unit&) const {}
    __device__ __forceinline__ void done(const Unit&) const {}
};

__device__ __forceinline__ unsigned cvt_pk_bf16(float lo, float hi) { unsigned r; asm volatile("v_cvt_pk_bf16_f32 %0, %1, %2" : "=v"(r) : "v"(lo), "v"(hi)); return r; }
typedef float f32x2 __attribute__((ext_vector_type(2)));
__device__ __forceinline__ f32x2 gelu_pk(f32x2 v) {
    const f32x2 av = __builtin_elementwise_abs(v), d = av * 0.2316418882f + 1.0f;
    f32x2 t; t.x = __builtin_amdgcn_rcpf(d.x); t.y = __builtin_amdgcn_rcpf(d.y);
    f32x2 q = t * 0.5307027145f + (-0.7265760135f); q = q * t + 0.7107068705f; q = q * t + (-0.142248368f); q = q * t + 0.127414796f; q = q * t;
    const f32x2 s = (v * v) * (-0.72134752044f);
    f32x2 e; e.x = __builtin_amdgcn_exp2f(s.x); e.y = __builtin_amdgcn_exp2f(s.y);
    const f32x2 m = v * (q * e), r = v - m;
    f32x2 o; o.x = v.x < 0.f ? m.x : r.x; o.y = v.y < 0.f ? m.y : r.y; return o;
}

template <int ACT  > struct EpiBf16 {
    static constexpr bool PERM = true, AFTER_DRAIN = false; static_assert(ACT == 0 || ACT == 1, "EpiBf16: ACT is 0 (none) or 1 (gelu_pk)");
    bf16_t* O; int ldc; const float* bias; int split_cols; size_t split_stride; float scale0;
    __device__ __forceinline__ void pre(const Unit&, int, int, float (&)[8]) const {}
    __device__ __forceinline__ void operator()(const f32x4 (&acc)[2][2][4][2], const Unit& u, int wr, int wc, int fr, int fq, const float (&)[8]) const {
        const int row0 = u.pm * BM + wr * 64 + fr; int colt = u.pn * BM; bf16_t* base = O;
        float sc = 1.f; if (split_cols) { const int t = colt / split_cols; base += (size_t)t * split_stride; colt -= t * split_cols; if (t == 0) sc = scale0; }
        const int col0 = colt + wc * 32 + 8 * fq, bcol0 = u.pn * BM + wc * 32 + 8 * fq;
        f32x4 bv[2][2];
#pragma unroll
        for (int bj = 0; bj < 2; ++bj)
#pragma unroll
            for (int n = 0; n < 2; ++n) bv[bj][n] = bias ? *(const f32x4*)(bias + bcol0 + bj * HALF + 4 * n) : (f32x4){0.f, 0.f, 0.f, 0.f};
#pragma unroll
        for (int ai = 0; ai < 2; ++ai)
#pragma unroll
            for (int m = 0; m < 4; ++m) { bf16_t* rowp = base + (size_t)(row0 + ai * HALF + m * 16) * ldc + col0;
#pragma unroll
                for (int bj = 0; bj < 2; ++bj) { f32x4 v0 = acc[ai][bj][m][0] + bv[bj][0], v1 = acc[ai][bj][m][1] + bv[bj][1];
                    if (ACT == 1) { f32x2 a = gelu_pk((f32x2){v0[0], v0[1]}), b = gelu_pk((f32x2){v0[2], v0[3]}), c = gelu_pk((f32x2){v1[0], v1[1]}), d = gelu_pk((f32x2){v1[2], v1[3]});
                        v0 = (f32x4){a.x, a.y, b.x, b.y}; v1 = (f32x4){c.x, c.y, d.x, d.y}; }
                    v0 = v0 * sc; v1 = v1 * sc; u32x4 w; w.x = cvt_pk_bf16(v0[0], v0[1]); w.y = cvt_pk_bf16(v0[2], v0[3]); w.z = cvt_pk_bf16(v1[0], v1[1]); w.w = cvt_pk_bf16(v1[2], v1[3]);
                    *(u32x4*)(rowp + bj * HALF) = w; } }
    }
};
__device__ __forceinline__ float silu_f(float x) { return x * __builtin_amdgcn_rcpf(1.0f + __builtin_amdgcn_exp2f(-1.4426950408889634f * x)); }
struct EpiSwiglu {
    static constexpr bool PERM = true, AFTER_DRAIN = false;
    bf16_t* O; int ldc; const unsigned long long* rs;
    __device__ __forceinline__ void pre(const Unit& u, int wr, int fr, float (&epf)[8]) const {
#pragma unroll
        for (int k = 0; k < 8; ++k) epf[k] = (float)rs[u.pm * BM + wr * 64 + fr + (k >> 2) * HALF + (k & 3) * 16] * (1.0f / 1048576.0f);
    }
    __device__ __forceinline__ void operator()(const f32x4 (&acc)[2][2][4][2], const Unit& u, int wr, int wc, int fr, int fq, const float (&epf)[8]) const {
        const int row0 = u.pm * BM + wr * 64 + fr; const int col0 = u.pn * HALF + wc * 32 + 8 * fq;
#pragma unroll
        for (int ai = 0; ai < 2; ++ai)
#pragma unroll
            for (int m = 0; m < 4; ++m) { const int row = row0 + ai * HALF + m * 16; bf16_t* rowp = O + (size_t)row * ldc + col0;
                const float r = rsqrtf(epf[ai * 4 + m] * (1.0f / 1024.0f) + 1e-6f);
                const f32x4 g0 = acc[ai][0][m][0] * r, g1 = acc[ai][0][m][1] * r, u0 = acc[ai][1][m][0] * r, u1 = acc[ai][1][m][1] * r;
                u32x4 w; w.x = cvt_pk_bf16(silu_f(g0[0]) * u0[0], silu_f(g0[1]) * u0[1]); w.y = cvt_pk_bf16(silu_f(g0[2]) * u0[2], silu_f(g0[3]) * u0[3]);
                w.z = cvt_pk_bf16(silu_f(g1[0]) * u1[0], silu_f(g1[1]) * u1[1]); w.w = cvt_pk_bf16(silu_f(g1[2]) * u1[2], silu_f(g1[3]) * u1[3]);
                *(u32x4*)rowp = w; }
    }
};
struct EpiRowScale {
    static constexpr bool PERM = true, AFTER_DRAIN = false;
    bf16_t* O; int ldc; const unsigned long long* rs;
    __device__ __forceinline__ void pre(const Unit& u, int wr, int fr, float (&epf)[8]) const {
#pragma unroll
        for (int k = 0; k < 8; ++k) epf[k] = (float)rs[u.pm * BM + wr * 64 + fr + (k >> 2) * HALF + (k & 3) * 16] * (1.0f / 1048576.0f);
    }
    __device__ __forceinline__ void operator()(const f32x4 (&acc)[2][2][4][2], const Unit& u, int wr, int wc, int fr, int fq, const float (&epf)[8]) const {
        const int row0 = u.pm * BM + wr * 64 + fr; const int col0 = u.pn * BM + wc * 32 + 8 * fq;
#pragma unroll
        for (int ai = 0; ai < 2; ++ai)
#pragma unroll
            for (int m = 0; m < 4; ++m) { const int row = row0 + ai * HALF + m * 16; bf16_t* rowp = O + (size_t)row * ldc + col0;
                const float r = rsqrtf(epf[ai * 4 + m] * (1.0f / 1024.0f) + 1e-6f);
#pragma unroll
                for (int bj = 0; bj < 2; ++bj) { const f32x4 v0 = acc[ai][bj][m][0] * r, v1 = acc[ai][bj][m][1] * r;
                    u32x4 w; w.x = cvt_pk_bf16(v0[0], v0[1]); w.y = cvt_pk_bf16(v0[2], v0[3]); w.z = cvt_pk_bf16(v1[0], v1[1]); w.w = cvt_pk_bf16(v1[2], v1[3]);
                    *(u32x4*)(rowp + bj * HALF) = w; } }
    }
};
struct EpiResid {
    static constexpr bool PERM = false, AFTER_DRAIN = false;
    bf16_t* xb; float* outf; int ldc; float scale; unsigned long long* rsn;
    __device__ __forceinline__ void pre(const Unit&, int, int, float (&)[8]) const {}
    __device__ __forceinline__ void operator()(const f32x4 (&acc)[2][2][4][2], const Unit& u, int wr, int wc, int fr, int fq, const float (&)[8]) const {
        const int row0 = u.pm * BM + wr * 64 + fr; const int col0 = u.pn * BM + wc * 32 + 4 * fq;
        typedef unsigned u32x2v __attribute__((ext_vector_type(2)));
#pragma unroll
        for (int ai = 0; ai < 2; ++ai)
#pragma unroll
            for (int m = 0; m < 4; ++m) { const int row = row0 + ai * HALF + m * 16; const size_t off = (size_t)row * ldc + col0; float ss = 0.f;
                u32x2v bs[2][2];
#pragma unroll
                for (int bj = 0; bj < 2; ++bj)
#pragma unroll
                    for (int n = 0; n < 2; ++n) bs[bj][n] = *(const u32x2v*)(xb + off + bj * HALF + n * 16);
#pragma unroll
                for (int bj = 0; bj < 2; ++bj)
#pragma unroll
                    for (int n = 0; n < 2; ++n) { const f32x4 b4 = (f32x4){__uint_as_float(bs[bj][n].x << 16), __uint_as_float(bs[bj][n].x & 0xffff0000u), __uint_as_float(bs[bj][n].y << 16), __uint_as_float(bs[bj][n].y & 0xffff0000u)};
                        const f32x4 v = b4 + acc[ai][bj][m][n] * scale;
                        if (outf) { *(f32x4*)(outf + off + bj * HALF + n * 16) = v; }
                        else { u32x2v w; w.x = cvt_pk_bf16(v[0], v[1]); w.y = cvt_pk_bf16(v[2], v[3]); *(u32x2v*)(xb + off + bj * HALF + n * 16) = w;
                            const float r0 = __uint_as_float(w.x << 16), r1 = __uint_as_float(w.x & 0xffff0000u), r2 = __uint_as_float(w.y << 16), r3 = __uint_as_float(w.y & 0xffff0000u);
                            ss += (r0 * r0 + r1 * r1) + (r2 * r2 + r3 * r3); } }
                if (rsn) { ss += __shfl_xor(ss, 16); ss += __shfl_xor(ss, 32); if (fq == 0) atomicAdd(rsn + row, (unsigned long long)(ss * 1048576.0f + 0.5f)); } }
    }
};
template <class Epi, class Sched, bool ALIGN_EPI = false, bool SP2 = false>
__device__ __forceinline__ void gemm_phase(PG8_LAS unsigned char* lds, const Gemm g, const Sched& S, const Epi& E) {
    int tid_l = threadIdx.x; asm volatile("" : "+v"(tid_l));
    const int tid = tid_l, wid = __builtin_amdgcn_readfirstlane(tid >> 6), lane = tid & 63, wr = wid >> 2, wc = wid & 3, fr = lane & 15, fq = lane >> 4;
    const int K = g.K, nt = K / BK;
    unsigned voffA[2], voffB[2];
#pragma unroll
    for (int i = 0; i < 2; ++i) { int R, C; stage_rc(tid * 16 + i * 8192, R, C); const int Rb = Epi::PERM ? ((R & ~31) + perm32(R & 31)) : R;
        voffA[i] = (unsigned)(R * K + C) * 2u; voffB[i] = (unsigned)(Rb * K + C) * 2u; }
    const size_t kstep = (size_t)(BK * 2);
    const size_t hstep = (size_t)HALF * K * 2;
    const size_t tstep = 2 * hstep;
    const unsigned ldsw = (unsigned)wid * 1024u;
    const int aoff = lds_byte(wr * 64 + fr, fq * 8), boff = lds_byte(wc * 32 + fr, fq * 8);
#define PG8_SA(b, h) (((b) * 2 + (h)) * HTB)
#define PG8_SB(b, h) ((4 + (b) * 2 + (h)) * HTB)
#define PG8_STAGE(bufoff, gbase, voff) do { _Pragma("unroll") for (int _i = 0; _i < 2; ++_i) \
        __builtin_amdgcn_global_load_lds((const unsigned*)((const char*)(gbase) + (voff)[_i]), (PG8_LAS unsigned*)(lds + (bufoff) + ldsw + _i * 8192), 16, 0, 0); } while (0)
#define PG8_LDA(dst, b, h) do { _Pragma("unroll") for (int m = 0; m < 4; ++m) _Pragma("unroll") for (int k = 0; k < 2; ++k) dst[m][k] = *(const PG8_LAS bf16x8*)(lds + PG8_SA(b, h) + aoff + m * 2048 + k * 1024); } while (0)
#define PG8_LDB(dst, b, h) do { _Pragma("unroll") for (int n = 0; n < 2; ++n) _Pragma("unroll") for (int k = 0; k < 2; ++k) dst[n][k] = *(const PG8_LAS bf16x8*)(lds + PG8_SB(b, h) + boff + n * 2048 + k * 1024); } while (0)
#define PG8_MMA(ai, bj, At, Bt) do { __builtin_amdgcn_s_setprio(1); _Pragma("unroll") for (int m = 0; m < 4; ++m) _Pragma("unroll") for (int n = 0; n < 2; ++n) _Pragma("unroll") for (int k = 0; k < 2; ++k) \
        acc[ai][bj][m][n] = __builtin_amdgcn_mfma_f32_16x16x32_bf16(Bt[n][k], At[m][k], acc[ai][bj][m][n], 0, 0, 0); __builtin_amdgcn_s_setprio(0); } while (0)
#define PG8_WAIT_V(n) asm volatile("s_waitcnt vmcnt(" #n ")" ::: "memory")
#define PG8_WAIT_L(n) asm volatile("s_waitcnt lgkmcnt(" #n ")" ::: "memory")
#define PG8_BAR __builtin_amdgcn_s_barrier()
#define PG8_SCHED __builtin_amdgcn_sched_barrier(0)
    Unit cur, nxt; int ui = 0;
    if (!S.next(0, cur)) return;
    float epf[8]; E.pre(cur, wr, fr, epf);
    f32x4 acc[2][2][4][2];
#pragma unroll
    for (int a = 0; a < 2; ++a)
#pragma unroll
        for (int b = 0; b < 2; ++b)
#pragma unroll
            for (int m = 0; m < 4; ++m)
#pragma unroll
                for (int n = 0; n < 2; ++n) acc[a][b][m][n] = (f32x4){0.f, 0.f, 0.f, 0.f};
    bf16x8 At[4][2], B0[2][2], B1[2][2];
    const char* cA = (const char*)g.A + (size_t)cur.pm * tstep; const char* cB = (const char*)g.Bt + (size_t)cur.pn * tstep;
    S.a_ready(cur);
    if constexpr (SP2) {
        PG8_STAGE(PG8_SB(0, 0), cB, voffB); PG8_STAGE(PG8_SB(0, 1), cB + hstep, voffB); PG8_STAGE(PG8_SA(0, 0), cA, voffA); PG8_STAGE(PG8_SA(0, 1), cA + hstep, voffA);
        if (wr == 1) PG8_BAR;
        PG8_WAIT_V(2); PG8_BAR;
        PG8_STAGE(PG8_SB(1, 0), cB + kstep, voffB); PG8_STAGE(PG8_SA(1, 0), cA + kstep, voffA); PG8_STAGE(PG8_SB(1, 1), cB + hstep + kstep, voffB);
        PG8_WAIT_V(6); PG8_BAR;
    } else {
        PG8_STAGE(PG8_SB(0, 0), cB, voffB); PG8_STAGE(PG8_SA(0, 0), cA, voffA); PG8_STAGE(PG8_SB(0, 1), cB + hstep, voffB); PG8_STAGE(PG8_SA(0, 1), cA + hstep, voffA);
        if (wr == 1) PG8_BAR;
        PG8_WAIT_V(4); PG8_BAR;
        PG8_STAGE(PG8_SB(1, 0), cB + kstep, voffB); PG8_STAGE(PG8_SA(1, 0), cA + kstep, voffA); PG8_STAGE(PG8_SB(1, 1), cB + hstep + kstep, voffB);
        PG8_WAIT_V(6); PG8_BAR;
    }
    for (;;) {
        const bool has_next = S.next(ui + 1, nxt);
        const char* nA = has_next ? (const char*)g.A + (size_t)nxt.pm * tstep : cA; const char* nB = has_next ? (const char*)g.Bt + (size_t)nxt.pn * tstep : cB;
        for (int t = 0; t < nt; t += 2) {
            const bool last = (t == nt - 2);
            const char* a1 = cA + (size_t)(t + 1) * kstep;
            const char* a2 = last ? nA : cA + (size_t)(t + 2) * kstep; const char* b2 = last ? nB : cB + (size_t)(t + 2) * kstep;
            const char* a3 = a2 + kstep; const char* b3 = b2 + kstep;
            if (last && has_next) S.a_ready(nxt);
            if constexpr (SP2) {
            PG8_LDB(B0, 0, 0); PG8_LDB(B1, 0, 1); PG8_SCHED; PG8_LDA(At, 0, 0); PG8_STAGE(PG8_SA(1, 1), a1 + hstep, voffA);
            PG8_WAIT_V(8); PG8_WAIT_L(0); PG8_BAR; PG8_MMA(0, 0, At, B0); PG8_MMA(0, 1, At, B1); PG8_BAR; PG8_SCHED;
            PG8_LDA(At, 0, 1); PG8_STAGE(PG8_SB(0, 0), b2, voffB); PG8_STAGE(PG8_SB(0, 1), b2 + hstep, voffB); PG8_STAGE(PG8_SA(0, 0), a2, voffA);
            PG8_WAIT_V(8); PG8_WAIT_L(0); PG8_BAR; PG8_MMA(1, 0, At, B0); PG8_MMA(1, 1, At, B1); PG8_BAR; PG8_SCHED;
            PG8_LDB(B0, 1, 0); PG8_LDB(B1, 1, 1); PG8_SCHED; PG8_LDA(At, 1, 0); PG8_STAGE(PG8_SA(0, 1), a2 + hstep, voffA);
            PG8_WAIT_V(8); PG8_WAIT_L(0); PG8_BAR; PG8_MMA(0, 0, At, B0); PG8_MMA(0, 1, At, B1); PG8_BAR; PG8_SCHED;
            PG8_LDA(At, 1, 1); PG8_STAGE(PG8_SB(1, 0), b3, voffB); PG8_STAGE(PG8_SB(1, 1), b3 + hstep, voffB); PG8_STAGE(PG8_SA(1, 0), a3, voffA);
            PG8_WAIT_V(8); PG8_WAIT_L(0); PG8_BAR; PG8_MMA(1, 0, At, B0); PG8_MMA(1, 1, At, B1); PG8_BAR; PG8_SCHED;
            } else {
            PG8_LDB(B0, 0, 0); PG8_SCHED; PG8_LDA(At, 0, 0); PG8_STAGE(PG8_SA(1, 1), a1 + hstep, voffA);
            PG8_WAIT_L(8); PG8_BAR; PG8_WAIT_L(0); PG8_MMA(0, 0, At, B0); PG8_BAR; PG8_SCHED;
            PG8_LDB(B1, 0, 1); PG8_STAGE(PG8_SB(0, 0), b2, voffB);
            PG8_BAR; PG8_WAIT_L(0); PG8_MMA(0, 1, At, B1); PG8_BAR;
            PG8_LDA(At, 0, 1); PG8_STAGE(PG8_SA(0, 0), a2, voffA);
            PG8_BAR; PG8_WAIT_L(0); PG8_MMA(1, 0, At, B0); PG8_BAR; PG8_SCHED;
            PG8_STAGE(PG8_SB(0, 1), b2 + hstep, voffB);
            PG8_WAIT_V(6); PG8_BAR; PG8_MMA(1, 1, At, B1); PG8_BAR;
            PG8_LDB(B0, 1, 0); PG8_SCHED; PG8_LDA(At, 1, 0); PG8_STAGE(PG8_SA(0, 1), a2 + hstep, voffA);
            PG8_WAIT_L(8); PG8_BAR; PG8_WAIT_L(0); PG8_MMA(0, 0, At, B0); PG8_BAR; PG8_SCHED;
            PG8_LDB(B1, 1, 1); PG8_STAGE(PG8_SB(1, 0), b3, voffB);
            PG8_BAR; PG8_WAIT_L(0); PG8_MMA(0, 1, At, B1); PG8_BAR;
            PG8_LDA(At, 1, 1); PG8_STAGE(PG8_SA(1, 0), a3, voffA);
            PG8_BAR; PG8_WAIT_L(0); PG8_MMA(1, 0, At, B0); PG8_BAR; PG8_SCHED;
            PG8_STAGE(PG8_SB(1, 1), b3 + hstep, voffB);
            PG8_WAIT_V(6); PG8_BAR; PG8_MMA(1, 1, At, B1); PG8_BAR;
            }
        }
        if constexpr (ALIGN_EPI) { if (wr == 0) PG8_BAR; }
        if constexpr (!Epi::AFTER_DRAIN) { E(acc, cur, wr, wc, fr, fq, epf); S.done(cur); }
        if (!has_next) break;
#pragma unroll
        for (int a = 0; a < 2; ++a)
#pragma unroll
            for (int b = 0; b < 2; ++b)
#pragma unroll
                for (int m = 0; m < 4; ++m)
#pragma unroll
                    for (int n = 0; n < 2; ++n) acc[a][b][m][n] = (f32x4){0.f, 0.f, 0.f, 0.f};
        cur = nxt; cA = nA; cB = nB; ++ui;
        E.pre(cur, wr, fr, epf);
        if constexpr (ALIGN_EPI) { if (wr == 1) PG8_BAR; }
    }
    PG8_WAIT_V(0);
    if constexpr (!ALIGN_EPI) { if (wr == 0) PG8_BAR; }
    PG8_BAR;
    if constexpr (Epi::AFTER_DRAIN) { E.fused(acc, cur, wr, wc, fr, fq, lds, wid, lane); S.done(cur); }
#undef PG8_SA
#undef PG8_SB
#undef PG8_STAGE
#undef PG8_LDA
#undef PG8_LDB
#undef PG8_MMA
#undef PG8_WAIT_V
#undef PG8_WAIT_L
#undef PG8_BAR
#undef PG8_SCHED
}
}

#define LAS __attribute__((address_space(3)))
typedef LAS unsigned char* ldsp;
typedef unsigned short bf16;
typedef short bf16x8 __attribute__((ext_vector_type(8)));
typedef float f32x4 __attribute__((ext_vector_type(4)));
typedef float f32x16 __attribute__((ext_vector_type(16)));
typedef unsigned u32x4 __attribute__((ext_vector_type(4)));
typedef unsigned u32x2 __attribute__((ext_vector_type(2)));
typedef float f32x2_t __attribute__((ext_vector_type(2)));
typedef __bf16 bf16x2_t __attribute__((ext_vector_type(2)));

constexpr int NBATCH = 4, L = 8192, M = NBATCH * L, D = 1024, FF = 2816, NUP = 2 * FF, NP = 3840, NPG = 3584, NLAYER = 2;
constexpr float EPS = 1e-6f, LOG2E = 1.4426950408889634f;
constexpr int PC_AQ = 0, PC_AK = 256, PC_AV = 512, PC_AG = 768, PC_BQ = 1024, PC_BK = 1280, PC_BV = 1536, PC_CZ = 1792, PC_XBC = 2048,
              PC_DB = 2816, PC_DC = 3072, PC_DV = 3328, PC_ALR = 3584, PC_BF = 3600, PC_DT = 3604;
constexpr size_t MiB = 1u << 20;
constexpr size_t WS_W = 1 * MiB, W_LSTRIDE = 42 * MiB + 512 * 1024;
constexpr size_t WO_1U = 0, WO_1D = 11 * MiB, WO_IN = 16 * MiB + 512 * 1024, WO_OUT = 24 * MiB, WO_2U = 26 * MiB, WO_2D = 37 * MiB;
constexpr size_t WS_RS = 489 * MiB;
constexpr size_t WS_XN = 86 * MiB;
constexpr size_t WS_HP = 150 * MiB;
constexpr size_t WS_XG2 = WS_HP + 176 * MiB;
constexpr size_t WS_VT = 390 * MiB;
constexpr size_t WS_GST = 406 * MiB;
constexpr size_t WS_GD = 438 * MiB;
constexpr size_t WS_SST = 439 * MiB;
constexpr size_t WS_SD = 471 * MiB;
constexpr size_t WS_FRAW = 471 * MiB + 65536;
constexpr size_t WS_FL = 472 * MiB;
constexpr size_t WS_XS = 473 * MiB;
constexpr size_t WS_END = 491 * MiB;
constexpr int LDS_BYTES = 150 * 1024;
constexpr int NTHREADS = 512;

template <class T> __device__ __forceinline__ T lds_ld(ldsp p, int off) { return *(const LAS T*)(p + off); }
template <class T> __device__ __forceinline__ void lds_st(ldsp p, int off, T v) { *(LAS T*)(p + off) = v; }
__device__ __forceinline__ ldsp lds_opaque(ldsp p) { unsigned a = (unsigned)(size_t)p; asm volatile("" : "+v"(a)); return (ldsp)(size_t)a; }
__device__ __forceinline__ float bf2f(bf16 u) { return __uint_as_float((unsigned)u << 16); }
__device__ __forceinline__ unsigned pk2(float lo, float hi) { f32x2_t v = {lo, hi}; bf16x2_t b = __builtin_convertvector(v, bf16x2_t); return __builtin_bit_cast(unsigned, b); }
__device__ __forceinline__ bf16 f2bf(float f) { return (bf16)(pk2(f, 0.f) & 0xffffu); }
__device__ __forceinline__ float lo16(unsigned w) { return __uint_as_float(w << 16); }
__device__ __forceinline__ float hi16(unsigned w) { return __uint_as_float(w & 0xffff0000u); }
__device__ __forceinline__ bf16x8 pack8(float a0, float a1, float a2, float a3, float a4, float a5, float a6, float a7) {
    u32x4 w; w.x = pk2(a0, a1); w.y = pk2(a2, a3); w.z = pk2(a4, a5); w.w = pk2(a6, a7); return __builtin_bit_cast(bf16x8, w); }
__device__ __forceinline__ bf16x8 cat2(u32x2 a, u32x2 b) { u32x4 w; w.x = a.x; w.y = a.y; w.z = b.x; w.w = b.y; return __builtin_bit_cast(bf16x8, w); }
__device__ __forceinline__ float silu(float x) { return x / (1.0f + __expf(-x)); }
__device__ __forceinline__ float logsigmoid(float x) { return fminf(x, 0.f) - log1pf(__expf(-fabsf(x))); }
__device__ __forceinline__ float softplus(float x) { return fmaxf(x, 0.f) + log1pf(__expf(-fabsf(x))); }
__device__ __forceinline__ int crow(int r, int hi) { return (r & 3) + 8 * (r >> 2) + 4 * hi; }
#define MFMA32(a, b, c) __builtin_amdgcn_mfma_f32_32x32x16_bf16((a), (b), (c), 0, 0, 0)
__device__ __forceinline__ void unpack8(u32x4 w, float (&o)[8]) { o[0] = lo16(w.x); o[1] = hi16(w.x); o[2] = lo16(w.y); o[3] = hi16(w.y); o[4] = lo16(w.z); o[5] = hi16(w.z); o[6] = lo16(w.w); o[7] = hi16(w.w); }

struct Ctx {
    unsigned char* ws;
    ldsp lds; int tid, lane, wave, nblk, blk;
};

__device__ __forceinline__ Ctx relaunder(const Ctx& C0) { Ctx C = C0; int t = C0.tid; asm volatile("" : "+v"(t)); C.tid = t; C.lane = t & 63; C.wave = __builtin_amdgcn_readfirstlane(t >> 6); return C; }

__device__ __forceinline__ int win_src_col(int j) {
    if (j < 1024) return j;
    if (j < 1792) return j + 16;
    if (j < 2816) return j + 20;
    if (j < 3584) return j + 24;
    if (j < 3600) return 1024 + (j - 3584);
    if (j < 3604) return 1808 + (j - 3600);
    if (j < 3608) return 2836 + (j - 3604);
    return -1;
}
__device__ __forceinline__ void wt_item(int kind, const float* W0, const float* W1, const float* gsc, int K, int Nsrc, int Ndst, bf16* WT, ldsp scr, int item, int lane) {
    const int nblk = Ndst / 32, kb = item / nblk, nb = item % nblk, k0 = 64 * kb, n0 = 32 * nb;
    const int nd = n0 + (lane & 31);
    const float* src = W0; int col = nd;
    if (kind == 1) { const int pn = nd >> 8, bj = (nd >> 7) & 1, cc = nd & 127; src = bj ? W1 : W0; col = pn * 128 + cc; }
    else if (kind == 2) { col = win_src_col(nd); }
    float vv[32];
#pragma unroll
    for (int i = 0; i < 32; ++i) { const int kk = 2 * i + (lane >> 5); vv[i] = (col >= 0) ? src[(size_t)(k0 + kk) * Nsrc + col] : 0.f; }
    float gs = 1.f; const float* gp = gsc ? gsc + k0 + (lane >> 5) : nullptr;
#pragma unroll
    for (int i = 0; i < 32; ++i) { const int kk = 2 * i + (lane >> 5); if (gp) gs = gp[2 * i]; lds_st<float>(scr, (kk * 33 + (lane & 31)) * 4, vv[i] * gs); }
    asm volatile("s_waitcnt lgkmcnt(0)" ::: "memory");
    const int c = lane & 7;
#pragma unroll
    for (int j = 0; j < 4; ++j) { const int n = (lane >> 3) + 8 * j; const int so = ((8 * c) * 33 + n) * 4;
        u32x4 o; o.x = pk2(lds_ld<float>(scr, so), lds_ld<float>(scr, so + 33 * 4)); o.y = pk2(lds_ld<float>(scr, so + 2 * 33 * 4), lds_ld<float>(scr, so + 3 * 33 * 4));
        o.z = pk2(lds_ld<float>(scr, so + 4 * 33 * 4), lds_ld<float>(scr, so + 5 * 33 * 4)); o.w = pk2(lds_ld<float>(scr, so + 6 * 33 * 4), lds_ld<float>(scr, so + 7 * 33 * 4));
        *(u32x4*)(WT + (size_t)(n0 + n) * K + k0 + 8 * c) = o; }
    asm volatile("s_waitcnt lgkmcnt(0)" ::: "memory");
}
struct Args { const float* in[27]; float* out; unsigned char* ws; int ph_lo, ph_hi; };
__device__ __forceinline__ const float* in_ptr(const Args& a, int k) { asm volatile("" : "+s"(k)); return a.in[k]; }
__device__ __forceinline__ void prologue(const Ctx& C, const Args& A) {
    ldsp scr = C.lds + C.wave * 8448;
    const int gw = C.blk * 8 + C.wave, NGW = C.nblk * 8;
    constexpr int I_U = 16 * (NUP / 32), I_D = (FF / 64) * 32, I_IN = 16 * (NP / 32), I_O = 16 * 32, I_L = 2 * I_U + 2 * I_D + I_IN + I_O;
    for (int it = gw; it < NLAYER * I_L; it += NGW) {
        const int l = it / I_L; int r = it % I_L;
        unsigned char* wb = C.ws + WS_W + (size_t)l * W_LSTRIDE;
        const size_t o_gu = (size_t)l * D * FF, o_dn = (size_t)l * FF * D;
        if (r < I_U) { wt_item(1, in_ptr(A, 2) + o_gu, in_ptr(A, 3) + o_gu, in_ptr(A, 1) + l * D, D, FF, NUP, (bf16*)(wb + WO_1U), scr, r, C.lane); continue; } r -= I_U;
        if (r < I_D) { wt_item(0, in_ptr(A, 4) + o_dn, nullptr, nullptr, FF, D, D, (bf16*)(wb + WO_1D), scr, r, C.lane); continue; } r -= I_D;
        if (r < I_IN) { wt_item(2, in_ptr(A, 6) + (size_t)l * D * 3608, nullptr, in_ptr(A, 5) + l * D, D, 3608, NP, (bf16*)(wb + WO_IN), scr, r, C.lane); continue; } r -= I_IN;
        if (r < I_O) { wt_item(0, in_ptr(A, 22) + (size_t)l * D * D, nullptr, nullptr, D, D, D, (bf16*)(wb + WO_OUT), scr, r, C.lane); continue; } r -= I_O;
        if (r < I_U) { wt_item(1, in_ptr(A, 24) + o_gu, in_ptr(A, 25) + o_gu, in_ptr(A, 23) + l * D, D, FF, NUP, (bf16*)(wb + WO_2U), scr, r, C.lane); continue; } r -= I_U;
        wt_item(0, in_ptr(A, 26) + o_dn, nullptr, nullptr, FF, D, D, (bf16*)(wb + WO_2D), scr, r, C.lane);
    }
}
__device__ __forceinline__ float wave_sum(float v) {
#pragma unroll
    for (int o = 1; o < 64; o <<= 1) v += __shfl_xor(v, o);
    return v;
}
__device__ __forceinline__ void norm_phase(const Ctx& C, const float* x, bf16* xb, unsigned long long* rs) {
    const int gw = C.blk * 8 + C.wave, NGW = C.nblk * 8;
    for (int m = 4 * gw; m < M; m += 4 * NGW) {
        f32x4 v[4][4];
#pragma unroll
        for (int q = 0; q < 4; ++q) { const f32x4* xr = (const f32x4*)(x + (size_t)(m + q) * D) + C.lane;
#pragma unroll
            for (int j = 0; j < 4; ++j) v[q][j] = xr[64 * j]; }
#pragma unroll
        for (int q = 0; q < 4; ++q) { u32x2* o8 = (u32x2*)(xb + (size_t)(m + q) * D) + C.lane; float s = 0.f;
#pragma unroll
            for (int j = 0; j < 4; ++j) { const f32x4 t = v[q][j]; u32x2 w; w.x = pk2(t.x, t.y); w.y = pk2(t.z, t.w); o8[64 * j] = w;
                const float r0 = lo16(w.x), r1 = hi16(w.x), r2 = lo16(w.y), r3 = hi16(w.y); s += (r0 * r0 + r1 * r1) + (r2 * r2 + r3 * r3); }
            s = wave_sum(s);
            if (C.lane == 0) rs[m + q] = (unsigned long long)(s * 1048576.0f + 0.5f); }
    }
}
#define XB_TMO      128
#define XB_XCNT(j)  (256  + 64 * (j))
#define XB_XSUB(j)  (1280 + 64 * (j))
#define XB_XGEN(j)  (2304 + 64 * (j))
#define XB_TOP      3328
#define XB_TOPGEN   3392
#define XCD_BAR_WORDS 3456
#define XB_SPIN_CAP (1u << 18)

__device__ __forceinline__ unsigned xb_ld(unsigned* p)              { return __hip_atomic_load(p, __ATOMIC_RELAXED, __HIP_MEMORY_SCOPE_AGENT); }
__device__ __forceinline__ unsigned xb_add(unsigned* p, unsigned v) { return __hip_atomic_fetch_add(p, v, __ATOMIC_RELAXED, __HIP_MEMORY_SCOPE_AGENT); }
__device__ __forceinline__ unsigned xb_xcc_id() { return (unsigned)__builtin_amdgcn_s_getreg((3 << 11) | 20) & 0xFu; }
#define XB_SPIN(cond, bar) do { unsigned _sp = 0; while (cond) { __builtin_amdgcn_s_sleep(1); \
    if ((++_sp & 255u) == 0u) { if (xb_ld(&(bar)[XB_TMO])) break; if (_sp > XB_SPIN_CAP) { atomicAdd(&(bar)[XB_TMO], 1u); break; } } } } while (0)

struct XcdBarrier {
    unsigned* bar; unsigned x;
    volatile LAS unsigned* st;
};

__device__ __forceinline__ XcdBarrier xcd_barrier_post(unsigned* bar, volatile LAS unsigned* st) {
    XcdBarrier b; b.bar = bar; b.x = xb_xcc_id(); b.st = st;
    if (threadIdx.x == 0) (void)xb_add(&bar[XB_XCNT(b.x)], 1u);
    return b;
}
__device__ __forceinline__ void xcd_barrier_complete(unsigned* bar, unsigned x, unsigned& nloc, unsigned& nx) {
    const unsigned G = gridDim.x * gridDim.y * gridDim.z;
    unsigned sum, cnt, mine, sp = 0u;
    for (;;) {
        sum = 0u; cnt = 0u; mine = 0u;
#pragma unroll
        for (unsigned j = 0; j < 16; ++j) { const unsigned c = xb_ld(&bar[XB_XCNT(j)]); sum += c; cnt += (c > 0u) ? 1u : 0u; mine = (j == x) ? c : mine; }
        if (sum == G) break;
        __builtin_amdgcn_s_sleep(1);
        if ((++sp & 255u) == 0u) { if (xb_ld(&bar[XB_TMO])) break; if (sp > XB_SPIN_CAP) { atomicAdd(&bar[XB_TMO], 1u); break; } }
    }
    nloc = mine > 0u ? mine : 1u; nx = cnt > 0u ? cnt : 1u;
}

__device__ __forceinline__ void xcd_barrier(const XcdBarrier& b) {
    asm volatile("s_waitcnt vmcnt(0)" ::: "memory");
    __syncthreads();
    if (threadIdx.x == 0) {
        unsigned* bar = b.bar;
        __builtin_amdgcn_s_waitcnt(0);
        unsigned nloc = b.st[0], nx = b.st[1];
        if (nloc == 0u) { xcd_barrier_complete(bar, b.x, nloc, nx); b.st[0] = nloc; b.st[1] = nx; }
        const unsigned old = xb_add(&bar[XB_XSUB(b.x)], 1u);
        const unsigned gen = old / nloc;
        if (old + 1u == (gen + 1u) * nloc) {
            __builtin_amdgcn_fence(__ATOMIC_RELEASE, "agent");
            asm volatile("s_waitcnt vmcnt(0)" ::: "memory");
            const unsigned og = xb_add(&bar[XB_TOP], 1u);
            const unsigned tg = og / nx;
            if (og + 1u == (tg + 1u) * nx) xb_add(&bar[XB_TOPGEN], 1u);
            else XB_SPIN(xb_ld(&bar[XB_TOPGEN]) == tg, bar);
            __builtin_amdgcn_fence(__ATOMIC_ACQUIRE, "agent");
            xb_add(&bar[XB_XGEN(b.x)], 1u);
            asm volatile("s_waitcnt vmcnt(0)" ::: "memory");
        } else {
            XB_SPIN(xb_ld(&bar[XB_XGEN(b.x)]) == gen, bar);
            __builtin_amdgcn_fence(__ATOMIC_ACQUIRE, "agent");
            asm volatile("s_waitcnt vmcnt(0)" ::: "memory");
        }
    }
    __syncthreads();
}

__device__ __forceinline__ void xcd_barrier_flatrel(const XcdBarrier& b, unsigned& kcount) {
    asm volatile("s_waitcnt vmcnt(0)" ::: "memory");
    __syncthreads();
    if (threadIdx.x == 0) {
        unsigned* bar = b.bar;
        __builtin_amdgcn_s_waitcnt(0);
        unsigned nloc = b.st[0], nx = b.st[1];
        if (nloc == 0u) { xcd_barrier_complete(bar, b.x, nloc, nx); b.st[0] = nloc; b.st[1] = nx; }
        const unsigned old = xb_add(&bar[XB_XSUB(b.x)], 1u);
        const unsigned gen = old / nloc;
        if (old + 1u == (gen + 1u) * nloc) {
            __builtin_amdgcn_fence(__ATOMIC_RELEASE, "agent");
            asm volatile("s_waitcnt vmcnt(0)" ::: "memory");
            const unsigned og = xb_add(&bar[XB_TOP], 1u);
            const unsigned tg = og / nx;
            if (og + 1u == (tg + 1u) * nx) xb_add(&bar[XB_TOPGEN], 1u);
        }
        const unsigned want = kcount + 1u;
        XB_SPIN(xb_ld(&bar[XB_TOPGEN]) < want, bar);
        __builtin_amdgcn_fence(__ATOMIC_ACQUIRE, "agent");
        asm volatile("s_waitcnt vmcnt(0)" ::: "memory");
    }
    __syncthreads();
    ++kcount;
}

constexpr int STG_ROW = 144, STG_BYTES = 32 * STG_ROW;
__device__ __forceinline__ void stage_write(ldsp st, const f32x16 (&o)[2], int r32, int hi) {
#pragma unroll
    for (int vt = 0; vt < 2; ++vt)
#pragma unroll
        for (int g = 0; g < 4; ++g) { u32x2 w; w.x = pk2(o[vt][4 * g], o[vt][4 * g + 1]); w.y = pk2(o[vt][4 * g + 2], o[vt][4 * g + 3]);
            lds_st<u32x2>(st, r32 * STG_ROW + (32 * vt + 8 * g + 4 * hi) * 2, w); }
}
__device__ __forceinline__ void load8f(const float* p, float (&o)[8]) { const f32x4 a = *(const f32x4*)p, b = *(const f32x4*)(p + 4); o[0] = a.x; o[1] = a.y; o[2] = a.z; o[3] = a.w; o[4] = b.x; o[5] = b.y; o[6] = b.z; o[7] = b.w; }
__device__ __forceinline__ bf16x8 ldg_f32_as_bf16x8(const float* p) { const f32x4 a = *(const f32x4*)p, b = *(const f32x4*)(p + 4); return pack8(a.x, a.y, a.z, a.w, b.x, b.y, b.z, b.w); }
__device__ __forceinline__ u32x4 pack8u(const float (&v)[8]) { u32x4 w; w.x = pk2(v[0], v[1]); w.y = pk2(v[2], v[3]); w.z = pk2(v[4], v[5]); w.w = pk2(v[6], v[7]); return w; }


__device__ __forceinline__ void small_gates_unit(const Ctx& C0, const bf16* Xb, const bf16* Wt, const unsigned long long* rs, bf16* P, int unit) {
    const Ctx C = relaunder(C0);
    typedef float f32x4v __attribute__((ext_vector_type(4)));
    const int r16 = C.lane & 15, kq = C.lane >> 4, m0 = 16 * unit;
    const bf16* ap = Wt + (size_t)(NPG + r16) * D + 8 * kq; const bf16* bp = Xb + (size_t)(m0 + r16) * D + 8 * kq;
    f32x4v acc0 = (f32x4v){0.f, 0.f, 0.f, 0.f}, acc1 = acc0;
#pragma unroll 1
    for (int half = 0; half < 2; ++half) {
        bf16x8 a0[16], a1[16], bb[16];
#pragma unroll
        for (int s = 0; s < 16; ++s) { const int ko = 32 * (16 * half + s); a0[s] = *(const bf16x8*)(ap + ko); a1[s] = *(const bf16x8*)(ap + (size_t)16 * D + ko); bb[s] = *(const bf16x8*)(bp + ko); }
#pragma unroll
        for (int s = 0; s < 16; ++s) { acc0 = __builtin_amdgcn_mfma_f32_16x16x32_bf16(a0[s], bb[s], acc0, 0, 0, 0); acc1 = __builtin_amdgcn_mfma_f32_16x16x32_bf16(a1[s], bb[s], acc1, 0, 0, 0); }
    }
    const float rstd = rsqrtf((float)rs[m0 + r16] * (1.0f / 1048576.0f) * (1.0f / 1024.0f) + EPS);
    bf16* o = P + (size_t)(m0 + r16) * NP + NPG + 4 * kq;
    { u32x2 w; w.x = pk2(acc0[0] * rstd, acc0[1] * rstd); w.y = pk2(acc0[2] * rstd, acc0[3] * rstd); *(u32x2*)o = w; }
    if (kq < 2) { u32x2 w; w.x = pk2(acc1[0] * rstd, acc1[1] * rstd); w.y = pk2(acc1[2] * rstd, acc1[3] * rstd); *(u32x2*)(o + 16) = w; }
}
__device__ __forceinline__ f32x4 sc_cv(const bf16* P, int m, int c) {
    const u32x2 a = *(const u32x2*)(P + (size_t)m * NP + PC_DC + c), b = *(const u32x2*)(P + (size_t)m * NP + PC_DV + c);
    return (f32x4){lo16(a.x) * lo16(b.x), hi16(a.x) * hi16(b.x), lo16(a.y) * lo16(b.y), hi16(a.y) * hi16(b.y)};
}
__device__ __forceinline__ void sc_unit(const Ctx& C0, const bf16* P, bf16* Y, const float* cw, const float* gn, int wu) {
    const Ctx C = relaunder(C0);
    const int c = 4 * C.lane, m0 = 32 * wu, t0 = m0 & (L - 1);
    const f32x4 w0 = *(const f32x4*)(cw + c), w1 = *(const f32x4*)(cw + 256 + c), w2 = *(const f32x4*)(cw + 512 + c), g = *(const f32x4*)(gn + c);
    f32x4 p2 = (f32x4){0.f, 0.f, 0.f, 0.f}, p1 = p2;
    if (t0 > 0) { p2 = sc_cv(P, m0 - 2, c); p1 = sc_cv(P, m0 - 1, c); }
    for (int i = 0; i < 32; ++i) {
        const int m = m0 + i; const f32x4 cv = sc_cv(P, m, c);
        const u32x2 bb = *(const u32x2*)(P + (size_t)m * NP + PC_DB + c);
        const f32x4 bg = (f32x4){lo16(bb.x), hi16(bb.x), lo16(bb.y), hi16(bb.y)};
        const f32x4 y = bg * (w0 * p2 + w1 * p1 + w2 * cv);
        float ss = (y.x * y.x + y.y * y.y) + (y.z * y.z + y.w * y.w);
        ss += __shfl_xor(ss, 1); ss += __shfl_xor(ss, 2); ss += __shfl_xor(ss, 4); ss += __shfl_xor(ss, 8);
        const float rstd = rsqrtf(ss * (1.f / 64.f) + EPS);
        u32x2 w; w.x = pk2(y.x * rstd * g.x, y.y * rstd * g.y); w.y = pk2(y.z * rstd * g.z, y.w * rstd * g.w);
        *(u32x2*)(Y + (size_t)m * D + 768 + c) = w;
        p2 = p1; p1 = cv;
    }
}
__device__ __forceinline__ void foxprep_unit(const Ctx& C0, const bf16* P, bf16* Vt, float* Fraw, const float* bfor, int wu) {
    const Ctx C = relaunder(C0);
    const int lane = C.lane, c = 4 * lane, h = lane >> 4, d = c & 63, m0 = 32 * wu, b = m0 / L, t0 = m0 & (L - 1);
    for (int i8 = 0; i8 < 4; ++i8) {
        u32x2 vraw[8];
#pragma unroll
        for (int j = 0; j < 8; ++j) vraw[j] = *(const u32x2*)(P + (size_t)(m0 + 8 * i8 + j) * NP + PC_BV + c);
        bf16* vrow = Vt + ((size_t)((b * 4 + h) * 64 + d)) * L + t0 + 8 * i8;
        u32x4 e0, e1, e2, e3;
#define FP_LO(a, b) (((a) & 0xffffu) | ((b) << 16))
#define FP_HI(a, b) (((a) >> 16) | ((b) & 0xffff0000u))
        e0.x = FP_LO(vraw[0].x, vraw[1].x); e0.y = FP_LO(vraw[2].x, vraw[3].x); e0.z = FP_LO(vraw[4].x, vraw[5].x); e0.w = FP_LO(vraw[6].x, vraw[7].x);
        e1.x = FP_HI(vraw[0].x, vraw[1].x); e1.y = FP_HI(vraw[2].x, vraw[3].x); e1.z = FP_HI(vraw[4].x, vraw[5].x); e1.w = FP_HI(vraw[6].x, vraw[7].x);
        e2.x = FP_LO(vraw[0].y, vraw[1].y); e2.y = FP_LO(vraw[2].y, vraw[3].y); e2.z = FP_LO(vraw[4].y, vraw[5].y); e2.w = FP_LO(vraw[6].y, vraw[7].y);
        e3.x = FP_HI(vraw[0].y, vraw[1].y); e3.y = FP_HI(vraw[2].y, vraw[3].y); e3.z = FP_HI(vraw[4].y, vraw[5].y); e3.w = FP_HI(vraw[6].y, vraw[7].y);
#undef FP_LO
#undef FP_HI
        *(u32x4*)(vrow) = e0; *(u32x4*)(vrow + L) = e1; *(u32x4*)(vrow + 2 * L) = e2; *(u32x4*)(vrow + 3 * L) = e3;
        if (lane < 32) { const int j = lane >> 2, hh = lane & 3; const int m = m0 + 8 * i8 + j;
            const float f = bf2f(P[(size_t)m * NP + PC_BF + hh]) + bfor[hh];
            Fraw[(size_t)(b * 4 + hh) * L + t0 + 8 * i8 + j] = logsigmoid(f); }
    }
}

constexpr int G_QD = 0, G_KD = 33792, G_VT = 67584, G_GLR = 104448, G_TOT = 108544, G_STG = 110592;
constexpr int GROW = 528, TROW = 144;
__device__ __forceinline__ float gla_la(ldsp GLR, int t, const float (&w2)[16], float bg) {
    float z = bg;
#pragma unroll
    for (int r4 = 0; r4 < 4; ++r4) { const f32x4 gl = lds_ld<f32x4>(GLR, (t * 16 + r4 * 4) * 4); z += gl.x * w2[4 * r4] + gl.y * w2[4 * r4 + 1] + gl.z * w2[4 * r4 + 2] + gl.w * w2[4 * r4 + 3]; }
    const float ls = fminf(z, 0.f) - __logf(1.0f + __expf(-fabsf(z)));
    return ls * (1.f / 16.f);
}
__device__ __forceinline__ void gla_gate(const Ctx& C, ldsp GLR, ldsp TOT, const bf16* P, const float* w2g, const float* bgate, int m0, int c, int th, float (&bb)[32], float& blast) {
    for (int e = C.tid; e < 1024; e += NTHREADS) { const int t = e >> 4, r = e & 15; lds_st<float>(GLR, e * 4, bf2f(P[(size_t)(m0 + t) * NP + PC_ALR + r])); }
    float w2[16];
#pragma unroll
    for (int r = 0; r < 16; ++r) w2[r] = w2g[r * 256 + c];
    const float bg = bgate[c];
    __syncthreads();
    float run = 0.f;
#pragma unroll
    for (int i = 0; i < 32; ++i) { run += gla_la(GLR, 32 * th + i, w2, bg); bb[i] = run; if (i & 1) __builtin_amdgcn_sched_barrier(0); }
    lds_st<float>(TOT, (th * 256 + c) * 4, run);
    __syncthreads();
    const float t0 = lds_ld<float>(TOT, c * 4), t1 = lds_ld<float>(TOT, (256 + c) * 4);
    if (th) {
#pragma unroll
        for (int i = 0; i < 32; ++i) bb[i] += t0;
    }
    blast = t0 + t1;
}
__device__ __forceinline__ void gla_passA(const Ctx& C0, const bf16* P, float* GST, float* GD, const float* w2g, const float* bgate, int unit) {
    const Ctx C = relaunder(C0);
    const int b = unit >> 7, n = unit & 127, m0 = b * L + 64 * n, c = C.tid & 255, th = C.tid >> 8;
    __syncthreads();
    const ldsp QD = lds_opaque(C.lds + G_QD), KD = lds_opaque(C.lds + G_KD), VT_ = lds_opaque(C.lds + G_VT), GLR = lds_opaque(C.lds + G_GLR), TOT = lds_opaque(C.lds + G_TOT);
    bf16 rk[32], rv[32];
#pragma unroll
    for (int i = 0; i < 32; ++i) { const size_t ro = (size_t)(m0 + 32 * th + i) * NP; rk[i] = P[ro + PC_AK + c]; rv[i] = P[ro + PC_AV + c]; }
    float bb[32], blast; gla_gate(C, GLR, TOT, P, w2g, bgate, m0, c, th, bb, blast);
#pragma unroll
    for (int i8 = 0; i8 < 4; ++i8) { float kk[8], vv[8];
#pragma unroll
        for (int j = 0; j < 8; ++j) { kk[j] = bf2f(rk[8 * i8 + j]) * __expf(blast - bb[8 * i8 + j]); vv[j] = bf2f(rv[8 * i8 + j]); }
        lds_st<u32x4>(QD, c * TROW + (32 * th + 8 * i8) * 2, pack8u(kk)); lds_st<u32x4>(VT_, c * TROW + (32 * th + 8 * i8) * 2, pack8u(vv)); }
    if (th == 0) GD[(size_t)((b * 128 + n) * 4 + (c >> 6)) * 64 + (c & 63)] = __expf(blast);
    __syncthreads();
    const int w = C.wave, h = w >> 1, dt = w & 1, r32 = C.lane & 31, hi = C.lane >> 5;
    f32x16 acc[2]; acc[0] = (f32x16){}; acc[1] = (f32x16){};
#pragma unroll
    for (int s = 0; s < 4; ++s) { const bf16x8 bf = lds_ld<bf16x8>(QD, (h * 64 + 32 * dt + r32) * TROW + (16 * s + 8 * hi) * 2);
#pragma unroll
        for (int vt = 0; vt < 2; ++vt) { const bf16x8 af = lds_ld<bf16x8>(VT_, (h * 64 + 32 * vt + r32) * TROW + (16 * s + 8 * hi) * 2); acc[vt] = MFMA32(af, bf, acc[vt]); } }
    float* st = GST + (size_t)((b * 128 + n) * 4 + h) * 4096;
#pragma unroll
    for (int vt = 0; vt < 2; ++vt)
#pragma unroll
        for (int r = 0; r < 16; ++r) st[(32 * vt + crow(r, hi)) * 64 + 32 * dt + r32] = acc[vt][r];
}
__device__ __forceinline__ void gla_passC(const Ctx& C0, const bf16* P, const bf16* GSB, bf16* Y, const float* w2g, const float* bgate, const float* gnorm, int unit) {
    const Ctx C = relaunder(C0);
    const int b = unit >> 7, n = unit & 127, m0 = b * L + 64 * n, c = C.tid & 255, th = C.tid >> 8;
    __syncthreads();
    const ldsp QD = lds_opaque(C.lds + G_QD), KD = lds_opaque(C.lds + G_KD), VT_ = lds_opaque(C.lds + G_VT), GLR = lds_opaque(C.lds + G_GLR), TOT = lds_opaque(C.lds + G_TOT);
    bf16x8 sfr[2][4];
    { const int w_ = C.wave, h_ = w_ >> 1, r32_ = C.lane & 31, hi_ = C.lane >> 5; const bf16* stb = GSB + (size_t)((b * 128 + n) * 4 + h_) * 4096;
#pragma unroll
      for (int vt = 0; vt < 2; ++vt)
#pragma unroll
        for (int s_ = 0; s_ < 4; ++s_) sfr[vt][s_] = *(const bf16x8*)(stb + (32 * vt + r32_) * 64 + 16 * s_ + 8 * hi_); }
    { bf16 rq[32], rk[32], rv[32];
#pragma unroll
      for (int i = 0; i < 32; ++i) { const size_t ro = (size_t)(m0 + 32 * th + i) * NP; rq[i] = P[ro + PC_AQ + c]; rk[i] = P[ro + PC_AK + c]; rv[i] = P[ro + PC_AV + c]; }
      float bb[32], blast; gla_gate(C, GLR, TOT, P, w2g, bgate, m0, c, th, bb, blast);
#pragma unroll
      for (int i8 = 0; i8 < 4; ++i8) { float vv[8];
#pragma unroll
        for (int j = 0; j < 8; ++j) { const int t = 32 * th + 8 * i8 + j; const float e = __expf(bb[8 * i8 + j]), ei = __expf(-bb[8 * i8 + j]);
            const float q = bf2f(rq[8 * i8 + j]) * 0.125f * e, k = bf2f(rk[8 * i8 + j]) * ei; vv[j] = bf2f(rv[8 * i8 + j]);
            lds_st<bf16>(QD, t * GROW + c * 2, f2bf(q)); lds_st<bf16>(KD, t * GROW + c * 2, f2bf(k)); }
        lds_st<u32x4>(VT_, c * TROW + (32 * th + 8 * i8) * 2, pack8u(vv)); } }
    __syncthreads();
    const int w = C.wave, h = w >> 1, ih = w & 1, r32 = C.lane & 31, hi = C.lane >> 5;
    bf16x8 qf[4];
#pragma unroll
    for (int s = 0; s < 4; ++s) qf[s] = lds_ld<bf16x8>(QD, (32 * ih + r32) * GROW + (h * 64 + 16 * s + 8 * hi) * 2);
    f32x16 o[2]; o[0] = (f32x16){}; o[1] = (f32x16){};
    u32x4 gpre[4];
#pragma unroll
    for (int it = 0; it < 4; ++it) gpre[it] = *(const u32x4*)(P + (size_t)(m0 + 32 * ih + 8 * it + (C.lane >> 3)) * NP + PC_AG + h * 64 + 8 * (C.lane & 7));
#pragma unroll
    for (int vt = 0; vt < 2; ++vt)
#pragma unroll
        for (int s = 0; s < 4; ++s) o[vt] = MFMA32(sfr[vt][s], qf[s], o[vt]);
    for (int jt = 0; jt <= ih; ++jt) {
        f32x16 X = (f32x16){};
#pragma unroll
        for (int s = 0; s < 4; ++s) { const bf16x8 kf = lds_ld<bf16x8>(KD, (32 * jt + r32) * GROW + (h * 64 + 16 * s + 8 * hi) * 2); X = MFMA32(kf, qf[s], X); }
        if (jt == ih) {
#pragma unroll
            for (int r = 0; r < 16; ++r) if (crow(r, hi) > r32) X[r] = 0.f;
        }
#pragma unroll
        for (int s2 = 0; s2 < 2; ++s2) { const bf16x8 pf = pack8(X[8 * s2], X[8 * s2 + 1], X[8 * s2 + 2], X[8 * s2 + 3], X[8 * s2 + 4], X[8 * s2 + 5], X[8 * s2 + 6], X[8 * s2 + 7]);
#pragma unroll
            for (int vt = 0; vt < 2; ++vt) { const int ao = (h * 64 + 32 * vt + r32) * TROW + (32 * jt + 16 * s2 + 4 * hi) * 2;
                const bf16x8 af = cat2(lds_ld<u32x2>(VT_, ao), lds_ld<u32x2>(VT_, ao + 16)); o[vt] = MFMA32(af, pf, o[vt]); } }
    }
    ldsp stg = C.lds + G_STG + w * STG_BYTES;
    stage_write(stg, o, r32, hi);
    asm volatile("s_waitcnt lgkmcnt(0)" ::: "memory");
#pragma unroll
    for (int it = 0; it < 4; ++it) { const int row = 8 * it + (C.lane >> 3), ch = 8 * (C.lane & 7); const int m = m0 + 32 * ih + row;
        float y[8], gt[8], gn[8]; unpack8(lds_ld<u32x4>(stg, row * STG_ROW + ch * 2), y); unpack8(gpre[it], gt); load8f(gnorm + h * 64 + ch, gn);
        float ss = 0.f;
#pragma unroll
        for (int e = 0; e < 8; ++e) ss += y[e] * y[e];
        ss += __shfl_xor(ss, 1); ss += __shfl_xor(ss, 2); ss += __shfl_xor(ss, 4);
        const float rstd = rsqrtf(ss * (1.f / 64.f) + EPS);
#pragma unroll
        for (int e = 0; e < 8; ++e) y[e] = y[e] * rstd * gn[e] * silu(gt[e]);
        *(u32x4*)(Y + (size_t)m * D + h * 64 + ch) = pack8u(y); }
}

constexpr int S_B = 0, S_C = 34816, S_X = 69632, S_AS = 104448, S_DT = 105472, S_ACS = 106496, S_SSX = 107520, S_STG = 108544;
constexpr int SROW = 272;
__device__ __forceinline__ void ssd_dt(const Ctx& C, ldsp SM, const bf16* P, const float* dtb, const float* Alog, int m0, int g) {
    const int hh = (C.tid >> 7) & 1, j = C.tid & 127;
    if (C.tid < 256) { const int h = 2 * g + hh; const float dtv = softplus(bf2f(P[(size_t)(m0 + j) * NP + PC_DT + h]) + dtb[h]);
        lds_st<float>(SM, (S_DT - S_AS) + (hh * 128 + j) * 4, dtv); lds_st<float>(SM, (S_AS - S_AS) + (hh * 128 + j) * 4, -__expf(Alog[h]) * dtv); }
    __syncthreads();
    if (C.tid < 256) { float v = lds_ld<float>(SM, (S_AS - S_AS) + (hh * 128 + j) * 4);
#pragma unroll
        for (int o_ = 1; o_ < 64; o_ <<= 1) { const float t_ = __shfl_up(v, o_); if (C.lane >= o_) v += t_; }
        if ((j & 64) == 0 && C.lane == 63) lds_st<float>(SM, (S_SSX - S_AS) + hh * 4, v);
        lds_st<float>(SM, (S_ACS - S_AS) + (hh * 128 + j) * 4, v); }
    __syncthreads();
    if (C.tid < 256 && (j & 64)) lds_st<float>(SM, (S_ACS - S_AS) + (hh * 128 + j) * 4, lds_ld<float>(SM, (S_ACS - S_AS) + (hh * 128 + j) * 4) + lds_ld<float>(SM, (S_SSX - S_AS) + hh * 4));
    __syncthreads();
}
template <bool PASS_C>
__device__ __forceinline__ void ssd_issue(const Ctx& C, const bf16* P, int m0, int n, int g, bf16 (&rawa)[PASS_C ? 3 : 2][35]) {
    constexpr int NCH = PASS_C ? 384 : 256, NIT = PASS_C ? 3 : 2;
#pragma unroll
    for (int k = 0; k < NIT; ++k) {
        const int item = C.tid + NTHREADS * k, ch = item % NCH, tq = item / NCH, typ = ch >> 7, cc = ch & 127, ci = typ * 256 + g * 128 + cc, pcol = PC_XBC + ci, j0 = 32 * tq;
        const bf16* pp = P + ((ptrdiff_t)(m0 + j0) - 3) * NP + pcol; const bool hasprev = (128 * n + j0 > 0);
#pragma unroll
        for (int t_ = 0; t_ < 35; ++t_) rawa[k][t_] = (t_ >= 3 || hasprev) ? pp[(ptrdiff_t)t_ * NP] : (bf16)0;
    }
}
template <bool PASS_C>
__device__ __forceinline__ void ssd_load(const Ctx& C, ldsp SB, ldsp SC, ldsp SX, ldsp SM, const bf16 (&rawa)[PASS_C ? 3 : 2][35], bf16* XS, const float* cw, const float* cb, int m0, int n, int g) {
    constexpr int NCH = PASS_C ? 384 : 256, NIT = PASS_C ? 3 : 2;
#pragma unroll
    for (int k = 0; k < NIT; ++k) {
        const int item = C.tid + NTHREADS * k, ch = item % NCH, tq = item / NCH, typ = ch >> 7, cc = ch & 127, ci = typ * 256 + g * 128 + cc;
        const float w0 = cw[ci], w1 = cw[768 + ci], w2 = cw[1536 + ci], w3 = cw[2304 + ci], bias = cb[ci];
        const int j0 = 32 * tq, hh = cc >> 6;
        const bf16 (&raw)[35] = rawa[k];
        float u3 = bf2f(raw[0]), u2 = bf2f(raw[1]), u1 = bf2f(raw[2]);
        const float alast = lds_ld<float>(SM, (S_ACS - S_AS) + (hh * 128 + 127) * 4);
#pragma unroll
        for (int i8 = 0; i8 < 4; ++i8) { float yv[8];
#pragma unroll
            for (int j = 0; j < 8; ++j) { const float u0 = bf2f(raw[3 + 8 * i8 + j]);
                yv[j] = silu(w0 * u3 + w1 * u2 + w2 * u1 + w3 * u0 + bias); u3 = u2; u2 = u1; u1 = u0; }
            const int jb = j0 + 8 * i8;
            if (typ == 0) {
#pragma unroll
                for (int j = 0; j < 8; ++j) { const float dtv = lds_ld<float>(SM, (S_DT - S_AS) + (hh * 128 + jb + j) * 4);
                    if (!PASS_C) { XS[(size_t)(m0 + jb + j) * 256 + g * 128 + cc] = f2bf(yv[j]); yv[j] *= dtv * __expf(alast - lds_ld<float>(SM, (S_ACS - S_AS) + (hh * 128 + jb + j) * 4)); }
                    else yv[j] *= dtv; }
                lds_st<u32x4>(SX, cc * SROW + jb * 2, pack8u(yv));
            } else if (!PASS_C) { lds_st<u32x4>(SB, cc * SROW + jb * 2, pack8u(yv)); }
            else { const ldsp base = (typ == 1) ? SB : SC;
#pragma unroll
                for (int j = 0; j < 8; ++j) lds_st<bf16>(base, (jb + j) * SROW + cc * 2, f2bf(yv[j])); }
        }
    }
}
__device__ __forceinline__ void ssd_passA(const Ctx& C0, const bf16* P, bf16* XS, float* SST, float* SD, const float* cw, const float* cb, const float* dtb, const float* Alog, int unit) {
    const Ctx C = relaunder(C0);
    const int b = unit >> 7, n = (unit >> 1) & 63, g = unit & 1, m0 = b * L + 128 * n;
    __syncthreads();
    const ldsp SB = lds_opaque(C.lds + S_B), SC = lds_opaque(C.lds + S_C), SX = lds_opaque(C.lds + S_X), SM = lds_opaque(C.lds + S_AS);
    bf16 rawa[2][35]; ssd_issue<false>(C, P, m0, n, g, rawa);
    ssd_dt(C, SM, P, dtb, Alog, m0, g);
    ssd_load<false>(C, SB, SC, SX, SM, rawa, XS, cw, cb, m0, n, g);
    if (C.tid < 2) SD[(size_t)(b * 64 + n) * 4 + 2 * g + C.tid] = __expf(lds_ld<float>(SM, (S_ACS - S_AS) + (C.tid * 128 + 127) * 4));
    __syncthreads();
    const int w = C.wave, hh = w >> 2, nt = w & 3, r32 = C.lane & 31, hi = C.lane >> 5;
    f32x16 acc[2]; acc[0] = (f32x16){}; acc[1] = (f32x16){};
#pragma unroll
    for (int s = 0; s < 8; ++s) { const bf16x8 bf = lds_ld<bf16x8>(SB, (32 * nt + r32) * SROW + (16 * s + 8 * hi) * 2);
#pragma unroll
        for (int pt = 0; pt < 2; ++pt) { const bf16x8 af = lds_ld<bf16x8>(SX, (hh * 64 + 32 * pt + r32) * SROW + (16 * s + 8 * hi) * 2); acc[pt] = MFMA32(af, bf, acc[pt]); } }
    float* st = SST + (size_t)((b * 64 + n) * 4 + 2 * g + hh) * 8192;
#pragma unroll
    for (int pt = 0; pt < 2; ++pt)
#pragma unroll
        for (int r = 0; r < 16; ++r) st[(32 * pt + crow(r, hi)) * 128 + 32 * nt + r32] = acc[pt][r];
}
__device__ __forceinline__ void ssd_passC(const Ctx& C0, const bf16* P, const bf16* XS, const bf16* SSB, bf16* Y, const float* cw, const float* cb, const float* dtb, const float* Alog, const float* Dsk, const float* gnorm, int unit) {
    const Ctx C = relaunder(C0);
    const int b = unit >> 7, n = (unit >> 1) & 63, g = unit & 1, m0 = b * L + 128 * n;
    __syncthreads();
    const ldsp SB = lds_opaque(C.lds + S_B), SC = lds_opaque(C.lds + S_C), SX = lds_opaque(C.lds + S_X), SM = lds_opaque(C.lds + S_AS);
    bf16x8 sfr[2][8];
    { const int w_ = C.wave, hh_ = w_ >> 2, r32_ = C.lane & 31, hi_ = C.lane >> 5; const bf16* stb = SSB + (size_t)((b * 64 + n) * 4 + 2 * g + hh_) * 8192;
#pragma unroll
      for (int pt = 0; pt < 2; ++pt)
#pragma unroll
        for (int s_ = 0; s_ < 8; ++s_) sfr[pt][s_] = *(const bf16x8*)(stb + (32 * pt + r32_) * 128 + 16 * s_ + 8 * hi_); }
    bf16 rawa[3][35]; ssd_issue<true>(C, P, m0, n, g, rawa);
    ssd_dt(C, SM, P, dtb, Alog, m0, g);
    ssd_load<true>(C, SB, SC, SX, SM, rawa, nullptr, cw, cb, m0, n, g);
    __syncthreads();
    const int w = C.wave, hh = w >> 2, it = w & 3, r32 = C.lane & 31, hi = C.lane >> 5, h = 2 * g + hh;
    const float acs_i = lds_ld<float>(SM, (S_ACS - S_AS) + (hh * 128 + 32 * it + r32) * 4);
    f32x16 o[2]; o[0] = (f32x16){}; o[1] = (f32x16){};
    u32x4 xpre[4], zpre[4];
#pragma unroll
    for (int q4 = 0; q4 < 4; ++q4) { const int m_ = m0 + 32 * it + 8 * q4 + (C.lane >> 3); const int ch_ = 8 * (C.lane & 7);
        xpre[q4] = *(const u32x4*)(XS + (size_t)m_ * 256 + g * 128 + hh * 64 + ch_); zpre[q4] = *(const u32x4*)(P + (size_t)m_ * NP + PC_CZ + g * 128 + hh * 64 + ch_); }
#pragma unroll
    for (int s = 0; s < 8; ++s) { const bf16x8 cf = lds_ld<bf16x8>(SC, (32 * it + r32) * SROW + (16 * s + 8 * hi) * 2);
#pragma unroll
        for (int pt = 0; pt < 2; ++pt) o[pt] = MFMA32(sfr[pt][s], cf, o[pt]); }
    { const float ei = __expf(acs_i);
#pragma unroll
      for (int r = 0; r < 16; ++r) { o[0][r] *= ei; o[1][r] *= ei; } }
    for (int jt = 0; jt <= it; ++jt) {
        f32x16 X = (f32x16){};
#pragma unroll
        for (int s = 0; s < 8; ++s) { const bf16x8 bf = lds_ld<bf16x8>(SB, (32 * jt + r32) * SROW + (16 * s + 8 * hi) * 2);
            const bf16x8 cf = lds_ld<bf16x8>(SC, (32 * it + r32) * SROW + (16 * s + 8 * hi) * 2); X = MFMA32(bf, cf, X); }
#pragma unroll
        for (int r = 0; r < 16; ++r) { const int jl = 32 * jt + crow(r, hi); const float aj = lds_ld<float>(SM, (S_ACS - S_AS) + (hh * 128 + jl) * 4);
            X[r] = (jl <= 32 * it + r32) ? X[r] * __expf(acs_i - aj) : 0.f; }
#pragma unroll
        for (int s2 = 0; s2 < 2; ++s2) { const bf16x8 pf = pack8(X[8 * s2], X[8 * s2 + 1], X[8 * s2 + 2], X[8 * s2 + 3], X[8 * s2 + 4], X[8 * s2 + 5], X[8 * s2 + 6], X[8 * s2 + 7]);
#pragma unroll
            for (int pt = 0; pt < 2; ++pt) { const int ao = (hh * 64 + 32 * pt + r32) * SROW + (32 * jt + 16 * s2 + 4 * hi) * 2;
                const bf16x8 af = cat2(lds_ld<u32x2>(SX, ao), lds_ld<u32x2>(SX, ao + 16)); o[pt] = MFMA32(af, pf, o[pt]); } }
    }
    ldsp stg = C.lds + S_STG + w * STG_BYTES;
    stage_write(stg, o, r32, hi);
    asm volatile("s_waitcnt lgkmcnt(0)" ::: "memory");
    float yy[4][8]; const float Dh = Dsk[h]; const int ch = 8 * (C.lane & 7);
#pragma unroll
    for (int q4 = 0; q4 < 4; ++q4) { const int row = 8 * q4 + (C.lane >> 3); const int m = m0 + 32 * it + row;
        float xs[8], z[8]; unpack8(lds_ld<u32x4>(stg, row * STG_ROW + ch * 2), yy[q4]); unpack8(xpre[q4], xs); unpack8(zpre[q4], z);
        float ss = 0.f;
#pragma unroll
        for (int e = 0; e < 8; ++e) { yy[q4][e] = (yy[q4][e] + xs[e] * Dh) * silu(z[e]); ss += yy[q4][e] * yy[q4][e]; }
        ss += __shfl_xor(ss, 1); ss += __shfl_xor(ss, 2); ss += __shfl_xor(ss, 4);
        if ((C.lane & 7) == 0) lds_st<float>(SM, (S_SSX - S_AS) + ((hh * 4 + it) * 32 + row) * 4, ss); }
    __syncthreads();
    float gn[8]; load8f(gnorm + g * 128 + hh * 64 + ch, gn);
#pragma unroll
    for (int q4 = 0; q4 < 4; ++q4) { const int row = 8 * q4 + (C.lane >> 3); const int m = m0 + 32 * it + row;
        const float ss = lds_ld<float>(SM, (S_SSX - S_AS) + ((0 * 4 + it) * 32 + row) * 4) + lds_ld<float>(SM, (S_SSX - S_AS) + ((1 * 4 + it) * 32 + row) * 4);
        const float rstd = rsqrtf(ss * (1.f / 128.f) + EPS);
#pragma unroll
        for (int e = 0; e < 8; ++e) yy[q4][e] = yy[q4][e] * rstd * gn[e];
        *(u32x4*)(Y + (size_t)m * D + 512 + g * 128 + hh * 64 + ch) = pack8u(yy[q4]); }
}

constexpr int F_FS = 0, F_BUF = 32768, F_KROW = 144, F_VROW = 400, F_KB = 192 * F_KROW, F_BUFB = F_KB + 64 * F_VROW, F_STG = F_BUF, F_FLAG = F_BUF + 2 * F_BUFB;
__device__ __forceinline__ u32x4 fox_knorm(u32x4 raw, const float (&g)[8]) {
    float v[8]; unpack8(raw, v); float ss = 0.f;
#pragma unroll
    for (int e = 0; e < 8; ++e) ss += v[e] * v[e];
    ss += __shfl_xor(ss, 1); ss += __shfl_xor(ss, 2); ss += __shfl_xor(ss, 4);
    const float r = rsqrtf(ss * (1.f / 64.f) + EPS);
#pragma unroll
    for (int e = 0; e < 8; ++e) v[e] = v[e] * r * g[e];
    return pack8u(v);
}
__device__ __forceinline__ void fox_attn_unit(const Ctx& C0, const bf16* P, const bf16* Vt, const float* Fl, bf16* Y, const float* qn, const float* kn, const float* on, int unit) {
    const Ctx C = relaunder(C0);
    const int bh = unit >> 5, qb = unit & 31, b = bh >> 2, h = bh & 3, q0 = qb * 256, nk = q0 + 256, w = C.wave, r32 = C.lane & 31, hi = C.lane >> 5;
    __syncthreads();
    const float* Flg = Fl + (size_t)bh * L;
    { f32x4 fv[4];
#pragma unroll
      for (int k = 0; k < 4; ++k) { const int i = 4 * C.tid + 4 * NTHREADS * k; if (i < nk) fv[k] = *(const f32x4*)(Flg + i); }
#pragma unroll
      for (int k = 0; k < 4; ++k) { const int i = 4 * C.tid + 4 * NTHREADS * k; if (i < nk) lds_st<f32x4>(C.lds, F_FS + i * 4, fv[k]); } }
    float gm = fabsf(qn[C.lane]), km = fabsf(kn[C.lane]);
#pragma unroll
    for (int o_ = 1; o_ < 64; o_ <<= 1) { gm = fmaxf(gm, __shfl_xor(gm, o_)); km = fmaxf(km, __shfl_xor(km, o_)); }
    __syncthreads();
    const int q0w = q0 + 32 * w, ktlast = (q0w + 31) >> 6, ktlast_b = 4 * qb + 3;
    const float TH = 16.f * LOG2E * gm * km + 64.f;
    int lo, lo_b;
    { const float Fq0 = lds_ld<float>(C.lds, F_FS + q0w * 4); int a_ = 0, hb = ktlast;
      while (a_ < hb) { const int mid = (a_ + hb) >> 1; if (Fq0 - lds_ld<float>(C.lds, F_FS + (64 * mid + 63) * 4) >= -TH) hb = mid; else a_ = mid + 1; } lo = a_; }
    { const float Fq0 = lds_ld<float>(C.lds, F_FS + q0 * 4); int a_ = 0, hb = q0 >> 6;
      while (a_ < hb) { const int mid = (a_ + hb) >> 1; if (Fq0 - lds_ld<float>(C.lds, F_FS + (64 * mid + 63) * 4) >= -TH) hb = mid; else a_ = mid + 1; } lo_b = a_; }
    const float Flq = lds_ld<float>(C.lds, F_FS + (q0w + r32) * 4);
    const size_t mb = (size_t)b * L;
    bf16x8 qr[4];
    { u32x4 qraw[4]; float qv[4][8], qg[4][8]; float ss = 0.f;
#pragma unroll
      for (int d0 = 0; d0 < 4; ++d0) { qraw[d0] = *(const u32x4*)(P + (mb + q0w + r32) * NP + PC_BQ + h * 64 + 16 * d0 + 8 * hi); load8f(qn + 16 * d0 + 8 * hi, qg[d0]); }
#pragma unroll
      for (int d0 = 0; d0 < 4; ++d0) { unpack8(qraw[d0], qv[d0]);
#pragma unroll
        for (int e = 0; e < 8; ++e) ss += qv[d0][e] * qv[d0][e]; }
      ss += __shfl_xor(ss, 32);
      const float rq = rsqrtf(ss * (1.f / 64.f) + EPS) * (0.125f * LOG2E);
#pragma unroll
      for (int d0 = 0; d0 < 4; ++d0) {
#pragma unroll
        for (int e = 0; e < 8; ++e) qv[d0][e] = qv[d0][e] * rq * qg[d0][e];
        qr[d0] = __builtin_bit_cast(bf16x8, pack8u(qv[d0])); } }
    float kg8[8]; load8f(kn + (C.tid & 7) * 8, kg8);
    float mrun = -INFINITY, lrun = 0.f; f32x16 o[2]; o[0] = (f32x16){}; o[1] = (f32x16){};
    const int qrow = q0w + r32;
    const int nch = (ktlast_b - lo_b + 3) / 3;
    u32x4 st[6];
    const bf16* kg = P + (mb + (C.tid >> 3)) * NP + PC_BK + h * 64 + (C.tid & 7) * 8;
    const int vd = C.tid / 24, vs = C.tid % 24;
    const ldsp BUF = lds_opaque(C.lds + F_BUF);
#define FOX_LOAD(c_) do { const int kt0_ = lo_b + 3 * (c_); \
        _Pragma("unroll") for (int i = 0; i < 3; ++i) { if (kt0_ + i <= ktlast_b) st[i] = *(const u32x4*)(kg + (size_t)(64 * (kt0_ + i)) * NP); } \
        _Pragma("unroll") for (int i = 0; i < 3; ++i) { const int p_ = C.tid + 512 * i, d_ = p_ / 24, sg_ = p_ % 24; if (kt0_ + (sg_ >> 3) <= ktlast_b) st[3 + i] = *(const u32x4*)(Vt + ((size_t)(bh * 64 + d_)) * L + 64 * kt0_ + sg_ * 8); } } while (0)
#define FOX_STORE(c_, par_) do { const int kt0_ = lo_b + 3 * (c_); const int bo_ = ((par_) & 1) * F_BUFB; \
        _Pragma("unroll") for (int i = 0; i < 3; ++i) { if (kt0_ + i <= ktlast_b) lds_st<u32x4>(BUF, bo_ + ((C.tid >> 3) + 64 * i) * F_KROW + (C.tid & 7) * 16, fox_knorm(st[i], kg8)); } \
        _Pragma("unroll") for (int i = 0; i < 3; ++i) { const int p_ = C.tid + 512 * i, d_ = p_ / 24, sg_ = p_ % 24; if (kt0_ + (sg_ >> 3) <= ktlast_b) lds_st<u32x4>(BUF, bo_ + F_KB + d_ * F_VROW + sg_ * 16, st[3 + i]); } } while (0)
    (void)vd; (void)vs;
    const float qkb = 8.f * LOG2E * gm * km;
    if (C.tid == 0) lds_st<unsigned>(C.lds, F_FLAG, 0u);
    FOX_LOAD(nch - 1); FOX_STORE(nch - 1, 0);
    __syncthreads();
    bool active = true;
    for (int ci = 0; ci < nch; ++ci) {
        const int c = nch - 1 - ci;
        if (c > 0) FOX_LOAD(c - 1);
        const int bo = (ci & 1) * F_BUFB;
        for (int tl = 2; tl >= 0; --tl) {
            const int kt = lo_b + 3 * c + tl;
            if (!active || kt > ktlast) continue;
            if (kt < lo || __all(qkb + (Flq - lds_ld<float>(C.lds, F_FS + (64 * kt + 63) * 4)) < mrun - 48.f)) {
                active = false; if (C.lane == 0) __hip_atomic_fetch_add((LAS unsigned*)(C.lds + F_FLAG), 1u, __ATOMIC_RELAXED, __HIP_MEMORY_SCOPE_WORKGROUP); continue; }
            const int kbase = bo + (64 * tl + r32) * F_KROW + 16 * hi;
            f32x16 s0 = (f32x16){}, s1 = (f32x16){};
#pragma unroll
            for (int d0 = 0; d0 < 4; ++d0) { const bf16x8 k0 = lds_ld<bf16x8>(BUF, kbase + 32 * d0), k1 = lds_ld<bf16x8>(BUF, kbase + 32 * F_KROW + 32 * d0); s0 = MFMA32(k0, qr[d0], s0); s1 = MFMA32(k1, qr[d0], s1); }
#pragma unroll
            for (int g = 0; g < 4; ++g) { const f32x4 fa = lds_ld<f32x4>(C.lds, F_FS + (64 * kt + 8 * g + 4 * hi) * 4), fb = lds_ld<f32x4>(C.lds, F_FS + (64 * kt + 32 + 8 * g + 4 * hi) * 4);
                s0[4 * g] += Flq - fa.x; s0[4 * g + 1] += Flq - fa.y; s0[4 * g + 2] += Flq - fa.z; s0[4 * g + 3] += Flq - fa.w;
                s1[4 * g] += Flq - fb.x; s1[4 * g + 1] += Flq - fb.y; s1[4 * g + 2] += Flq - fb.z; s1[4 * g + 3] += Flq - fb.w; }
            if (64 * kt + 63 > q0w) {
#pragma unroll
                for (int r = 0; r < 16; ++r) { const int key = 64 * kt + crow(r, hi); if (key > qrow) s0[r] = -INFINITY; if (key + 32 > qrow) s1[r] = -INFINITY; }
            }
            float mx = fmaxf(s0[0], s1[0]);
#pragma unroll
            for (int r = 1; r < 16; ++r) mx = fmaxf(mx, fmaxf(s0[r], s1[r]));
            mx = fmaxf(mx, __shfl_xor(mx, 32));
            const float mnew = fmaxf(mrun, mx), alpha = __builtin_amdgcn_exp2f(mrun - mnew); mrun = mnew;
            float rs = 0.f;
#pragma unroll
            for (int r = 0; r < 16; ++r) { s0[r] = __builtin_amdgcn_exp2f(s0[r] - mnew); s1[r] = __builtin_amdgcn_exp2f(s1[r] - mnew); rs += s0[r] + s1[r]; }
            lrun = lrun * alpha + rs;
#pragma unroll
            for (int r = 0; r < 16; ++r) { o[0][r] *= alpha; o[1][r] *= alpha; }
            const int vbase = bo + F_KB + r32 * F_VROW + (64 * tl + 4 * hi) * 2;
#pragma unroll
            for (int s2 = 0; s2 < 2; ++s2) {
                const bf16x8 p0 = pack8(s0[8 * s2], s0[8 * s2 + 1], s0[8 * s2 + 2], s0[8 * s2 + 3], s0[8 * s2 + 4], s0[8 * s2 + 5], s0[8 * s2 + 6], s0[8 * s2 + 7]);
                const bf16x8 p1 = pack8(s1[8 * s2], s1[8 * s2 + 1], s1[8 * s2 + 2], s1[8 * s2 + 3], s1[8 * s2 + 4], s1[8 * s2 + 5], s1[8 * s2 + 6], s1[8 * s2 + 7]);
#pragma unroll
                for (int dt = 0; dt < 2; ++dt) { const int vo = vbase + dt * 32 * F_VROW + 32 * s2;
                    const bf16x8 a0 = cat2(lds_ld<u32x2>(BUF, vo), lds_ld<u32x2>(BUF, vo + 16)), a1 = cat2(lds_ld<u32x2>(BUF, vo + 64), lds_ld<u32x2>(BUF, vo + 80));
                    o[dt] = MFMA32(a0, p0, o[dt]); o[dt] = MFMA32(a1, p1, o[dt]); }
            }
        }
        if (c > 0) FOX_STORE(c - 1, ci + 1);
        __syncthreads();
        if (lds_ld<unsigned>(C.lds, F_FLAG) >= 8u) break;
    }
    __syncthreads();
#undef FOX_LOAD
#undef FOX_STORE
    const float ltot = lrun + __shfl_xor(lrun, 32), inv = 1.0f / ltot;
#pragma unroll
    for (int r = 0; r < 16; ++r) { o[0][r] *= inv; o[1][r] *= inv; }
    ldsp stg = C.lds + F_STG + w * STG_BYTES;
    stage_write(stg, o, r32, hi);
    asm volatile("s_waitcnt lgkmcnt(0)" ::: "memory");
#pragma unroll
    for (int it = 0; it < 4; ++it) { const int row = 8 * it + (C.lane >> 3), ch = 8 * (C.lane & 7); const size_t m = mb + q0w + row;
        float y[8], gn[8]; unpack8(lds_ld<u32x4>(stg, row * STG_ROW + ch * 2), y); load8f(on + h * 64 + ch, gn);
        float ss = 0.f;
#pragma unroll
        for (int e = 0; e < 8; ++e) ss += y[e] * y[e];
        ss += __shfl_xor(ss, 1); ss += __shfl_xor(ss, 2); ss += __shfl_xor(ss, 4);
        const float rstd = rsqrtf(ss * (1.f / 64.f) + EPS);
#pragma unroll
        for (int e = 0; e < 8; ++e) y[e] = y[e] * rstd * gn[e];
        *(u32x4*)(Y + m * D + 256 + h * 64 + ch) = pack8u(y); }
}

__device__ __forceinline__ void scan_phase(const Ctx& C, const float* GST, const float* GD, bf16* GSB, const float* SST, const float* SD, bf16* SSB, const float* Fraw, float* Fl) {
    if (C.tid < 256) {
    for (int e = C.blk * 256 + C.tid; e < 65536; e += C.nblk * 256) { const int b = e >> 14, h = (e >> 12) & 3, vd = e & 4095, d = vd & 63;
        const float* p = GST + ((size_t)(b * 128) * 4 + h) * 4096 + vd; bf16* pb = GSB + ((size_t)(b * 128) * 4 + h) * 4096 + vd; const float* dp = GD + ((size_t)(b * 128) * 4 + h) * 64 + d; float S = 0.f;
        for (int n0 = 0; n0 < 128; n0 += 32) { float kv[32], dc[32];
#pragma unroll
            for (int j = 0; j < 32; ++j) { kv[j] = p[(size_t)(n0 + j) * 16384]; dc[j] = dp[(n0 + j) * 256]; }
#pragma unroll
            for (int j = 0; j < 32; ++j) { pb[(size_t)(n0 + j) * 16384] = f2bf(S); S = S * dc[j] + kv[j]; } } }
    } else {
    for (int e = C.blk * 256 + (C.tid - 256); e < 131072; e += C.nblk * 256) { const int b = e >> 15, h = (e >> 13) & 3, pn = e & 8191;
        const float* p = SST + ((size_t)(b * 64) * 4 + h) * 8192 + pn; bf16* pb = SSB + ((size_t)(b * 64) * 4 + h) * 8192 + pn; const float* dp = SD + (size_t)(b * 64) * 4 + h; float S = 0.f;
        for (int n0 = 0; n0 < 64; n0 += 32) { float kv[32], dc[32];
#pragma unroll
            for (int j = 0; j < 32; ++j) { kv[j] = p[(size_t)(n0 + j) * 32768]; dc[j] = dp[(n0 + j) * 4]; }
#pragma unroll
            for (int j = 0; j < 32; ++j) { pb[(size_t)(n0 + j) * 32768] = f2bf(S); S = S * dc[j] + kv[j]; } } }
    }
    for (int bh = C.blk; bh < 16; bh += C.nblk) {
        __syncthreads();
        const float* src = Fraw + (size_t)bh * L + 16 * C.tid; float v[16]; float run = 0.f;
#pragma unroll
        for (int j4 = 0; j4 < 4; ++j4) { const f32x4 a = *(const f32x4*)(src + 4 * j4); run += a.x; v[4 * j4] = run; run += a.y; v[4 * j4 + 1] = run; run += a.z; v[4 * j4 + 2] = run; run += a.w; v[4 * j4 + 3] = run; }
        float incl = run;
#pragma unroll
        for (int o_ = 1; o_ < 64; o_ <<= 1) { const float t_ = __shfl_up(incl, o_); if (C.lane >= o_) incl += t_; }
        if (C.lane == 63) lds_st<float>(C.lds, C.wave * 4, incl);
        __syncthreads();
        float pre = incl - run;
        for (int w_ = 0; w_ < C.wave; ++w_) pre += lds_ld<float>(C.lds, w_ * 4);
        float* dst = Fl + (size_t)bh * L + 16 * C.tid;
#pragma unroll
        for (int j4 = 0; j4 < 4; ++j4) *(f32x4*)(dst + 4 * j4) = (f32x4){(pre + v[4 * j4]) * LOG2E, (pre + v[4 * j4 + 1]) * LOG2E, (pre + v[4 * j4 + 2]) * LOG2E, (pre + v[4 * j4 + 3]) * LOG2E};
    }
}

#ifndef MK_PER_PHASE
#define MK_PER_PHASE 0
#endif
#ifndef PH_MASK
#define PH_MASK 0xffff
#endif
#define EN(k) ((PH_MASK >> (k)) & 1)
#ifndef DUP
#define DUP 0
#endif
#define DUPN(k) (((DUP >> (k)) & 1) ? 2 : 1)
#ifndef DUPT
#define DUPT -1
#endif
#define REPT(k) for (int rt_ = 0; rt_ < ((DUPT == (k)) ? 2 : 1); ++rt_)
constexpr int NPHASE = 1 + 9 * NLAYER;

__global__ void __launch_bounds__(NTHREADS) mega(Args a) {
    extern __shared__ __attribute__((aligned(16))) unsigned char lds_raw[];
    cg::grid_group grid = cg::this_grid();
    LAS unsigned char* glds = (LAS unsigned char*)lds_raw;
    float* X = a.out;
    volatile LAS unsigned* bst = (volatile LAS unsigned*)((ldsp)lds_raw + LDS_BYTES - 64);
    if (threadIdx.x < 16) bst[threadIdx.x] = 0u;
    __syncthreads();
    XcdBarrier bar = xcd_barrier_post((unsigned*)a.ws, bst); unsigned nbar = 0u;

    if (a.ph_hi < 0) grid.sync();
    for (int ph = a.ph_lo; ph < a.ph_hi; ++ph) {
        Ctx C; { int tid_ = threadIdx.x, blk_ = blockIdx.x, nblk_ = gridDim.x; unsigned char* ws_ = a.ws;
            asm volatile("" : "+v"(tid_)); asm volatile("" : "+s"(blk_), "+s"(nblk_), "+s"(ws_));
            C.ws = ws_; C.lds = (ldsp)lds_raw; C.tid = tid_; C.lane = tid_ & 63; C.wave = __builtin_amdgcn_readfirstlane(tid_ >> 6); C.nblk = nblk_; C.blk = blk_; }
        unsigned char* ws = C.ws;
        bf16* XN = (bf16*)(ws + WS_XN); bf16* HP = (bf16*)(ws + WS_HP); bf16* VT = (bf16*)(ws + WS_VT); bf16* YB = (bf16*)X; bf16* GSB = (bf16*)((unsigned char*)X + 64 * MiB); bf16* SSB = (bf16*)((unsigned char*)X + 80 * MiB);
        float* GST = (float*)(ws + WS_GST); float* GD = (float*)(ws + WS_GD); float* SST = (float*)(ws + WS_SST); float* SD = (float*)(ws + WS_SD);
        float* FRAW = (float*)(ws + WS_FRAW); float* FL = (float*)(ws + WS_FL); bf16* XS = (bf16*)(ws + WS_XS); unsigned long long* RS = (unsigned long long*)(ws + WS_RS);
        if (ph == 0) {
            for (int rep = 0; rep < DUPN(6); ++rep) { if (EN(0)) prologue(C, a); }
            for (int i = C.blk * NTHREADS + C.tid; i < (NLAYER * 3 - 1) * M / 2; i += C.nblk * NTHREADS) ((u32x4*)(RS + M))[i] = (u32x4){0u, 0u, 0u, 0u};
            norm_phase(C, in_ptr(a, 0), XN, RS);
        } else {
            const int q = ph - 1, l = q / 9, s = q % 9;
            unsigned char* wb = ws + WS_W + (size_t)l * W_LSTRIDE;
            if (s == 0 || s == 7) {
                pg8::Gemm g{XN, (const bf16*)(wb + (s == 0 ? WO_1U : WO_2U)), M, NUP, D}; pg8::StaticOrder S; S.init(M, NUP, C.nblk, C.blk);
                pg8::EpiSwiglu E{HP, FF, RS + (size_t)(l * 3 + (s == 0 ? 0 : 2)) * M};
                for (int rep = 0; rep < DUPN(1); ++rep) { if (EN(2)) pg8::gemm_phase<pg8::EpiSwiglu, pg8::StaticOrder, true, true>(glds, g, S, E); }
            } else if (s == 1 || s == 8 || s == 6) {
                const bf16* A = (s == 6) ? YB : HP; const int K = (s == 6) ? D : FF;
                const bf16* Bt = (const bf16*)(wb + (s == 1 ? WO_1D : s == 6 ? WO_OUT : WO_2D));
                unsigned long long* rsn = (s == 1) ? RS + (size_t)(l * 3 + 1) * M : (s == 6) ? RS + (size_t)(l * 3 + 2) * M : (l + 1 < NLAYER) ? RS + (size_t)((l + 1) * 3) * M : nullptr;
                float* outf = (s == 8 && l + 1 == NLAYER) ? X : nullptr;
                pg8::Gemm g{A, Bt, M, D, K}; pg8::StaticOrder S; S.init(M, D, C.nblk, C.blk);
                pg8::EpiResid E{XN, outf, D, (s == 6) ? 1.0f : 0.5f, rsn};
                if (EN(3)) pg8::gemm_phase<pg8::EpiResid, pg8::StaticOrder, true, true>(glds, g, S, E);
            } else if (s == 2) {
                pg8::Gemm g{XN, (const bf16*)(wb + WO_IN), M, NPG, D}; pg8::StaticOrder S; S.init(M, NPG, C.nblk, C.blk);
                pg8::EpiRowScale E{HP, NP, RS + (size_t)(l * 3 + 1) * M};
                for (int rep = 0; rep < DUPN(2); ++rep) { if (EN(4)) pg8::gemm_phase<pg8::EpiRowScale, pg8::StaticOrder, true, true>(glds, g, S, E); }
                for (int u = C.blk * 8 + C.wave; u < M / 16; u += C.nblk * 8) small_gates_unit(C, XN, (const bf16*)(wb + WO_IN), RS + (size_t)(l * 3 + 1) * M, HP, u);
            } else if (s == 3) {
                const int vblk = (C.nblk % 8 == 0) ? (C.blk % 8) * (C.nblk / 8) + C.blk / 8 : C.blk;
                for (int u = vblk; u < 1024; u += C.nblk) {
                    if (u < 512) { if (EN(5)) REPT(5) gla_passA(C, HP, GST, GD, in_ptr(a, 7) + l * 16 * 256, in_ptr(a, 8) + l * 256, u); }
                    else if (EN(6)) REPT(6) ssd_passA(C, HP, XS, SST, SD, in_ptr(a, 14) + l * 4 * 768, in_ptr(a, 15) + l * 768, in_ptr(a, 16) + l * 4, in_ptr(a, 17) + l * 4, u - 512);
                }
                const int gw = C.blk * 8 + C.wave, NGW = C.nblk * 8;
                for (int u = gw; u < 2048; u += NGW) {
                    if (u < 1024) { if (EN(7)) REPT(7) sc_unit(C, HP, YB, in_ptr(a, 20) + l * 3 * 256, in_ptr(a, 21) + l * 256, u); }
                    else if (EN(8)) foxprep_unit(C, HP, VT, FRAW, in_ptr(a, 10) + l * 4, u - 1024);
                }
            } else if (s == 4) {
                if (EN(9)) scan_phase(C, GST, GD, GSB, SST, SD, SSB, FRAW, FL);
            } else {
                const int vblk = (C.nblk % 8 == 0) ? (C.blk % 8) * (C.nblk / 8) + C.blk / 8 : C.blk;
                for (int u = vblk; u < 1536; u += C.nblk) {
                    if (u < 512) { if (EN(10)) REPT(10) fox_attn_unit(C, HP, VT, FL, YB, in_ptr(a, 11) + l * 64, in_ptr(a, 12) + l * 64, in_ptr(a, 13) + l * 256, u); }
                    else if (u < 1024) { if (EN(11)) REPT(11) ssd_passC(C, HP, XS, SSB, YB, in_ptr(a, 14) + l * 4 * 768, in_ptr(a, 15) + l * 768, in_ptr(a, 16) + l * 4, in_ptr(a, 17) + l * 4, in_ptr(a, 18) + l * 4, in_ptr(a, 19) + l * 256, u - 512); }
                    else if (EN(12)) REPT(12) gla_passC(C, HP, GSB, YB, in_ptr(a, 7) + l * 16 * 256, in_ptr(a, 8) + l * 256, in_ptr(a, 9) + l * 256, u - 1024);
                }
            }
        }
        if (ph + 1 < a.ph_hi) { xcd_barrier_flatrel(bar, nbar); if (DUPN(5) == 2) xcd_barrier_flatrel(bar, nbar); }
    }
}

extern "C" void kernel_launch(void* const* d_in, const int* in_sizes, int n_in, void* d_out, int out_size, void* d_ws, size_t ws_size, hipStream_t stream) {
    static int grid = 0;
    if (grid == 0) {
        if (n_in != 27 || out_size != M * D || ws_size < WS_END) { fprintf(stderr, "kernel_launch: unexpected shapes (n_in %d out %d ws %zu)\n", n_in, out_size, ws_size); grid = -1; return; }
        int dev = 0, cus = 0, per_cu = 0;
        (void)hipGetDevice(&dev); (void)hipDeviceGetAttribute(&cus, hipDeviceAttributeMultiprocessorCount, dev);
        (void)hipFuncSetAttribute((const void*)mega, hipFuncAttributeMaxDynamicSharedMemorySize, LDS_BYTES);
        (void)hipOccupancyMaxActiveBlocksPerMultiprocessor(&per_cu, (const void*)mega, NTHREADS, LDS_BYTES);
        if (per_cu < 1) per_cu = 1;
        (void)hipGetLastError();
        grid = cus * per_cu;
    }
    if (grid < 0) return;
    Args a{};
    for (int i = 0; i < 27; ++i) a.in[i] = (const float*)d_in[i];
    a.out = (float*)d_out; a.ws = (unsigned char*)d_ws;
#if MK_PER_PHASE
    for (int ph = 0; ph < NPHASE; ++ph) { a.ph_lo = ph; a.ph_hi = ph + 1; hipLaunchKernelGGL(mega, dim3(grid), dim3(NTHREADS), LDS_BYTES, stream, a); }
#else
    a.ph_lo = 0; a.ph_hi = NPHASE;
    (void)hipMemsetAsync(d_ws, 0, 16384, stream);
    void* args[] = {&a};
    hipError_t e = hipLaunchCooperativeKernel((const void*)mega, dim3(grid), dim3(NTHREADS), args, LDS_BYTES, stream);
    if (e != hipSuccess) fprintf(stderr, "cooperative launch failed: %s (grid %d)\n", hipGetErrorString(e), grid);
#endif
}
```

```cpp
#include <hip/hip_runtime.h>
#include <hip/hip_cooperative_groups.h>
#include <cstdio>
#include <cstdint>
namespace cg = cooperative_groups;
namespace pg8 {
#define PG8_LAS __attribute__((address_space(3)))
typedef unsigned short bf16_t;
typedef short bf16x8 __attribute__((ext_vector_type(8)));
typedef float f32x4 __attribute__((ext_vector_type(4)));
typedef unsigned u32x4 __attribute__((ext_vector_type(4)));
constexpr int BM = 256, BK = 64, HALF = 128, HTB = HALF * BK * 2  , STAGE_BYTES = 8 * HTB, NXCD = 8, WGM = 8;

__host__ __device__ __forceinline__ int lds_byte(int r, int c) { const int st = (r >> 4) * 2 + (c >> 5), rr = r & 15, cc = c & 31, ob = rr * 64 + cc * 2; return st * 1024 + (ob ^ (((ob >> 9) & 1) << 5)); }
__host__ __device__ __forceinline__ void stage_rc(int b, int& R, int& C) { const int st = b / 1024, sb = b % 1024, swz = sb ^ (((sb >> 9) & 1) << 5); R = (st >> 1) * 16 + swz / 64; C = (st & 1) * 32 + (swz % 64) / 2; }
__host__ __device__ __forceinline__ int perm32(int rho) { const int n = rho >> 4, i = rho & 15; return 8 * (i >> 2) + 4 * n + (i & 3); }

struct Unit { int pm, pn; };
struct Gemm { const bf16_t* A; const bf16_t* Bt; int M, N, K; };

struct StaticOrder {
    int nM, nN, nwg, G, c;
    __host__ __device__ void init(int M, int N, int G_, int c_) { nM = M / BM; nN = N / BM; nwg = nM * nN; G = G_; c = c_; }
    __host__ __device__ bool next(int i, Unit& u) const {
        const long L = (long)i * G + c; if (L >= nwg) return false;
        int wgid = (int)L; { const int q = nwg / NXCD, r = nwg % NXCD, xcd = wgid % NXCD, off = wgid / NXCD; wgid = (xcd < r ? xcd * (q + 1) : r * (q + 1) + (xcd - r) * q) + off; }
        const int nig = WGM * nN, gid = wgid / nig, fm = gid * WGM, gsz = (nM - fm) < WGM ? (nM - fm) : WGM;
        u.pm = fm + ((wgid % nig) % gsz); u.pn = (wgid % nig) / gsz; return true;
    }
    __device__ __forceinline__ void a_ready(const Unit&) const {}
    __device__ __forceinline__ void done(const Unit&) const {}
};

__device__ __forceinline__ unsigned cvt_pk_bf16(float lo, float hi) { unsigned r; asm volatile("v_cvt_pk_bf16_f32 %0, %1, %2" : "=v"(r) : "v"(lo), "v"(hi)); return r; }
typedef float f32x2 __attribute__((ext_vector_type(2)));
__device__ __forceinline__ f32x2 gelu_pk(f32x2 v) {
    const f32x2 av = __builtin_elementwise_abs(v), d = av * 0.2316418882f + 1.0f;
    f32x2 t; t.x = __builtin_amdgcn_rcpf(d.x); t.y = __builtin_amdgcn_rcpf(d.y);
    f32x2 q = t * 0.5307027145f + (-0.7265760135f); q = q * t + 0.7107068705f; q = q * t + (-0.142248368f); q = q * t + 0.127414796f; q = q * t;
    const f32x2 s = (v * v) * (-0.72134752044f);
    f32x2 e; e.x = __builtin_amdgcn_exp2f(s.x); e.y = __builtin_amdgcn_exp2f(s.y);
    const f32x2 m = v * (q * e), r = v - m;
    f32x2 o; o.x = v.x < 0.f ? m.x : r.x; o.y = v.y < 0.f ? m.y : r.y; return o;
}

template <int ACT  > struct EpiBf16 {
    static constexpr bool PERM = true, AFTER_DRAIN = false; static_assert(ACT == 0 || ACT == 1, "EpiBf16: ACT is 0 (none) or 1 (gelu_pk)");
    bf16_t* O; int ldc; const float* bias; int split_cols; size_t split_stride; float scale0;
    __device__ __forceinline__ void pre(const Unit&, int, int, float (&)[8]) const {}
    __device__ __forceinline__ void operator()(const f32x4 (&acc)[2][2][4][2], const Unit& u, int wr, int wc, int fr, int fq, const float (&)[8]) const {
        const int row0 = u.pm * BM + wr * 64 + fr; int colt = u.pn * BM; bf16_t* base = O;
        float sc = 1.f; if (split_cols) { const int t = colt / split_cols; base += (size_t)t * split_stride; colt -= t * split_cols; if (t == 0) sc = scale0; }
        const int col0 = colt + wc * 32 + 8 * fq, bcol0 = u.pn * BM + wc * 32 + 8 * fq;
        f32x4 bv[2][2];
#pragma unroll
        for (int bj = 0; bj < 2; ++bj)
#pragma unroll
            for (int n = 0; n < 2; ++n) bv[bj][n] = bias ? *(const f32x4*)(bias + bcol0 + bj * HALF + 4 * n) : (f32x4){0.f, 0.f, 0.f, 0.f};
#pragma unroll
        for (int ai = 0; ai < 2; ++ai)
#pragma unroll
            for (int m = 0; m < 4; ++m) { bf16_t* rowp = base + (size_t)(row0 + ai * HALF + m * 16) * ldc + col0;
#pragma unroll
                for (int bj = 0; bj < 2; ++bj) { f32x4 v0 = acc[ai][bj][m][0] + bv[bj][0], v1 = acc[ai][bj][m][1] + bv[bj][1];
                    if (ACT == 1) { f32x2 a = gelu_pk((f32x2){v0[0], v0[1]}), b = gelu_pk((f32x2){v0[2], v0[3]}), c = gelu_pk((f32x2){v1[0], v1[1]}), d = gelu_pk((f32x2){v1[2], v1[3]});
                        v0 = (f32x4){a.x, a.y, b.x, b.y}; v1 = (f32x4){c.x, c.y, d.x, d.y}; }
                    v0 = v0 * sc; v1 = v1 * sc; u32x4 w; w.x = cvt_pk_bf16(v0[0], v0[1]); w.y = cvt_pk_bf16(v0[2], v0[3]); w.z = cvt_pk_bf16(v1[0], v1[1]); w.w = cvt_pk_bf16(v1[2], v1[3]);
                    *(u32x4*)(rowp + bj * HALF) = w; } }
    }
};
__device__ __forceinline__ float silu_f(float x) { return x * __builtin_amdgcn_rcpf(1.0f + __builtin_amdgcn_exp2f(-1.4426950408889634f * x)); }
struct EpiSwiglu {
    static constexpr bool PERM = true, AFTER_DRAIN = false;
    bf16_t* O; int ldc; const unsigned long long* rs;
    __device__ __forceinline__ void pre(const Unit& u, int wr, int fr, float (&epf)[8]) const {
#pragma unroll
        for (int k = 0; k < 8; ++k) epf[k] = (float)rs[u.pm * BM + wr * 64 + fr + (k >> 2) * HALF + (k & 3) * 16] * (1.0f / 1048576.0f);
    }
    __device__ __forceinline__ void operator()(const f32x4 (&acc)[2][2][4][2], const Unit& u, int wr, int wc, int fr, int fq, const float (&epf)[8]) const {
        const int row0 = u.pm * BM + wr * 64 + fr; const int col0 = u.pn * HALF + wc * 32 + 8 * fq;
#pragma unroll
        for (int ai = 0; ai < 2; ++ai)
#pragma unroll
            for (int m = 0; m < 4; ++m) { const int row = row0 + ai * HALF + m * 16; bf16_t* rowp = O + (size_t)row * ldc + col0;
                const float r = rsqrtf(epf[ai * 4 + m] * (1.0f / 1024.0f) + 1e-6f);
                const f32x4 g0 = acc[ai][0][m][0] * r, g1 = acc[ai][0][m][1] * r, u0 = acc[ai][1][m][0] * r, u1 = acc[ai][1][m][1] * r;
                u32x4 w; w.x = cvt_pk_bf16(silu_f(g0[0]) * u0[0], silu_f(g0[1]) * u0[1]); w.y = cvt_pk_bf16(silu_f(g0[2]) * u0[2], silu_f(g0[3]) * u0[3]);
                w.z = cvt_pk_bf16(silu_f(g1[0]) * u1[0], silu_f(g1[1]) * u1[1]); w.w = cvt_pk_bf16(silu_f(g1[2]) * u1[2], silu_f(g1[3]) * u1[3]);
                *(u32x4*)rowp = w; }
    }
};
struct EpiRowScale {
    static constexpr bool PERM = true, AFTER_DRAIN = false;
    bf16_t* O; int ldc; const unsigned long long* rs;
    __device__ __forceinline__ void pre(const Unit& u, int wr, int fr, float (&epf)[8]) const {
#pragma unroll
        for (int k = 0; k < 8; ++k) epf[k] = (float)rs[u.pm * BM + wr * 64 + fr + (k >> 2) * HALF + (k & 3) * 16] * (1.0f / 1048576.0f);
    }
    __device__ __forceinline__ void operator()(const f32x4 (&acc)[2][2][4][2], const Unit& u, int wr, int wc, int fr, int fq, const float (&epf)[8]) const {
        const int row0 = u.pm * BM + wr * 64 + fr; const int col0 = u.pn * BM + wc * 32 + 8 * fq;
#pragma unroll
        for (int ai = 0; ai < 2; ++ai)
#pragma unroll
            for (int m = 0; m < 4; ++m) { const int row = row0 + ai * HALF + m * 16; bf16_t* rowp = O + (size_t)row * ldc + col0;
                const float r = rsqrtf(epf[ai * 4 + m] * (1.0f / 1024.0f) + 1e-6f);
#pragma unroll
                for (int bj = 0; bj < 2; ++bj) { const f32x4 v0 = acc[ai][bj][m][0] * r, v1 = acc[ai][bj][m][1] * r;
                    u32x4 w; w.x = cvt_pk_bf16(v0[0], v0[1]); w.y = cvt_pk_bf16(v0[2], v0[3]); w.z = cvt_pk_bf16(v1[0], v1[1]); w.w = cvt_pk_bf16(v1[2], v1[3]);
                    *(u32x4*)(rowp + bj * HALF) = w; } }
    }
};
struct EpiResid {
    static constexpr bool PERM = false, AFTER_DRAIN = false;
    bf16_t* xb; float* outf; int ldc; float scale; unsigned long long* rsn;
    __device__ __forceinline__ void pre(const Unit&, int, int, float (&)[8]) const {}
    __device__ __forceinline__ void operator()(const f32x4 (&acc)[2][2][4][2], const Unit& u, int wr, int wc, int fr, int fq, const float (&)[8]) const {
        const int row0 = u.pm * BM + wr * 64 + fr; const int col0 = u.pn * BM + wc * 32 + 4 * fq;
        typedef unsigned u32x2v __attribute__((ext_vector_type(2)));
#pragma unroll
        for (int ai = 0; ai < 2; ++ai)
#pragma unroll
            for (int m = 0; m < 4; ++m) { const int row = row0 + ai * HALF + m * 16; const size_t off = (size_t)row * ldc + col0; float ss = 0.f;
                u32x2v bs[2][2];
#pragma unroll
                for (int bj = 0; bj < 2; ++bj)
#pragma unroll
                    for (int n = 0; n < 2; ++n) bs[bj][n] = *(const u32x2v*)(xb + off + bj * HALF + n * 16);
#pragma unroll
                for (int bj = 0; bj < 2; ++bj)
#pragma unroll
                    for (int n = 0; n < 2; ++n) { const f32x4 b4 = (f32x4){__uint_as_float(bs[bj][n].x << 16), __uint_as_float(bs[bj][n].x & 0xffff0000u), __uint_as_float(bs[bj][n].y << 16), __uint_as_float(bs[bj][n].y & 0xffff0000u)};
                        const f32x4 v = b4 + acc[ai][bj][m][n] * scale;
                        if (outf) { *(f32x4*)(outf + off + bj * HALF + n * 16) = v; }
                        else { u32x2v w; w.x = cvt_pk_bf16(v[0], v[1]); w.y = cvt_pk_bf16(v[2], v[3]); *(u32x2v*)(xb + off + bj * HALF + n * 16) = w;
                            const float r0 = __uint_as_float(w.x << 16), r1 = __uint_as_float(w.x & 0xffff0000u), r2 = __uint_as_float(w.y << 16), r3 = __uint_as_float(w.y & 0xffff0000u);
                            ss += (r0 * r0 + r1 * r1) + (r2 * r2 + r3 * r3); } }
                if (rsn) { ss += __shfl_xor(ss, 16); ss += __shfl_xor(ss, 32); if (fq == 0) atomicAdd(rsn + row, (unsigned long long)(ss * 1048576.0f + 0.5f)); } }
    }
};
template <class Epi, class Sched, bool ALIGN_EPI = false, bool SP2 = false>
__device__ __forceinline__ void gemm_phase(PG8_LAS unsigned char* lds, const Gemm g, const Sched& S, const Epi& E) {
    int tid_l = threadIdx.x; asm volatile("" : "+v"(tid_l));
    const int tid = tid_l, wid = __builtin_amdgcn_readfirstlane(tid >> 6), lane = tid & 63, wr = wid >> 2, wc = wid & 3, fr = lane & 15, fq = lane >> 4;
    const int K = g.K, nt = K / BK;
    unsigned voffA[2], voffB[2];
#pragma unroll
    for (int i = 0; i < 2; ++i) { int R, C; stage_rc(tid * 16 + i * 8192, R, C); const int Rb = Epi::PERM ? ((R & ~31) + perm32(R & 31)) : R;
        voffA[i] = (unsigned)(R * K + C) * 2u; voffB[i] = (unsigned)(Rb * K + C) * 2u; }
    const size_t kstep = (size_t)(BK * 2);
    const size_t hstep = (size_t)HALF * K * 2;
    const size_t tstep = 2 * hstep;
    const unsigned ldsw = (unsigned)wid * 1024u;
    const int aoff = lds_byte(wr * 64 + fr, fq * 8), boff = lds_byte(wc * 32 + fr, fq * 8);
#define PG8_SA(b, h) (((b) * 2 + (h)) * HTB)
#define PG8_SB(b, h) ((4 + (b) * 2 + (h)) * HTB)
#define PG8_STAGE(bufoff, gbase, voff) do { _Pragma("unroll") for (int _i = 0; _i < 2; ++_i) \
        __builtin_amdgcn_global_load_lds((const unsigned*)((const char*)(gbase) + (voff)[_i]), (PG8_LAS unsigned*)(lds + (bufoff) + ldsw + _i * 8192), 16, 0, 0); } while (0)
#define PG8_LDA(dst, b, h) do { _Pragma("unroll") for (int m = 0; m < 4; ++m) _Pragma("unroll") for (int k = 0; k < 2; ++k) dst[m][k] = *(const PG8_LAS bf16x8*)(lds + PG8_SA(b, h) + aoff + m * 2048 + k * 1024); } while (0)
#define PG8_LDB(dst, b, h) do { _Pragma("unroll") for (int n = 0; n < 2; ++n) _Pragma("unroll") for (int k = 0; k < 2; ++k) dst[n][k] = *(const PG8_LAS bf16x8*)(lds + PG8_SB(b, h) + boff + n * 2048 + k * 1024); } while (0)
#define PG8_MMA(ai, bj, At, Bt) do { __builtin_amdgcn_s_setprio(1); _Pragma("unroll") for (int m = 0; m < 4; ++m) _Pragma("unroll") for (int n = 0; n < 2; ++n) _Pragma("unroll") for (int k = 0; k < 2; ++k) \
        acc[ai][bj][m][n] = __builtin_amdgcn_mfma_f32_16x16x32_bf16(Bt[n][k], At[m][k], acc[ai][bj][m][n], 0, 0, 0); __builtin_amdgcn_s_setprio(0); } while (0)
#define PG8_WAIT_V(n) asm volatile("s_waitcnt vmcnt(" #n ")" ::: "memory")
#define PG8_WAIT_L(n) asm volatile("s_waitcnt lgkmcnt(" #n ")" ::: "memory")
#define PG8_BAR __builtin_amdgcn_s_barrier()
#define PG8_SCHED __builtin_amdgcn_sched_barrier(0)
    Unit cur, nxt; int ui = 0;
    if (!S.next(0, cur)) return;
    float epf[8]; E.pre(cur, wr, fr, epf);
    f32x4 acc[2][2][4][2];
#pragma unroll
    for (int a = 0; a < 2; ++a)
#pragma unroll
        for (int b = 0; b < 2; ++b)
#pragma unroll
            for (int m = 0; m < 4; ++m)
#pragma unroll
                for (int n = 0; n < 2; ++n) acc[a][b][m][n] = (f32x4){0.f, 0.f, 0.f, 0.f};
    bf16x8 At[4][2], B0[2][2], B1[2][2];
    const char* cA = (const char*)g.A + (size_t)cur.pm * tstep; const char* cB = (const char*)g.Bt + (size_t)cur.pn * tstep;
    S.a_ready(cur);
    if constexpr (SP2) {
        PG8_STAGE(PG8_SB(0, 0), cB, voffB); PG8_STAGE(PG8_SB(0, 1), cB + hstep, voffB); PG8_STAGE(PG8_SA(0, 0), cA, voffA); PG8_STAGE(PG8_SA(0, 1), cA + hstep, voffA);
        if (wr == 1) PG8_BAR;
        PG8_WAIT_V(2); PG8_BAR;
        PG8_STAGE(PG8_SB(1, 0), cB + kstep, voffB); PG8_STAGE(PG8_SA(1, 0), cA + kstep, voffA); PG8_STAGE(PG8_SB(1, 1), cB + hstep + kstep, voffB);
        PG8_WAIT_V(6); PG8_BAR;
    } else {
        PG8_STAGE(PG8_SB(0, 0), cB, voffB); PG8_STAGE(PG8_SA(0, 0), cA, voffA); PG8_STAGE(PG8_SB(0, 1), cB + hstep, voffB); PG8_STAGE(PG8_SA(0, 1), cA + hstep, voffA);
        if (wr == 1) PG8_BAR;
        PG8_WAIT_V(4); PG8_BAR;
        PG8_STAGE(PG8_SB(1, 0), cB + kstep, voffB); PG8_STAGE(PG8_SA(1, 0), cA + kstep, voffA); PG8_STAGE(PG8_SB(1, 1), cB + hstep + kstep, voffB);
        PG8_WAIT_V(6); PG8_BAR;
    }
    for (;;) {
        const bool has_next = S.next(ui + 1, nxt);
        const char* nA = has_next ? (const char*)g.A + (size_t)nxt.pm * tstep : cA; const char* nB = has_next ? (const char*)g.Bt + (size_t)nxt.pn * tstep : cB;
        for (int t = 0; t < nt; t += 2) {
            const bool last = (t == nt - 2);
            const char* a1 = cA + (size_t)(t + 1) * kstep;
            const char* a2 = last ? nA : cA + (size_t)(t + 2) * kstep; const char* b2 = last ? nB : cB + (size_t)(t + 2) * kstep;
            const char* a3 = a2 + kstep; const char* b3 = b2 + kstep;
            if (last && has_next) S.a_ready(nxt);
            if constexpr (SP2) {
            PG8_LDB(B0, 0, 0); PG8_LDB(B1, 0, 1); PG8_SCHED; PG8_LDA(At, 0, 0); PG8_STAGE(PG8_SA(1, 1), a1 + hstep, voffA);
            PG8_WAIT_V(8); PG8_WAIT_L(0); PG8_BAR; PG8_MMA(0, 0, At, B0); PG8_MMA(0, 1, At, B1); PG8_BAR; PG8_SCHED;
            PG8_LDA(At, 0, 1); PG8_STAGE(PG8_SB(0, 0), b2, voffB); PG8_STAGE(PG8_SB(0, 1), b2 + hstep, voffB); PG8_STAGE(PG8_SA(0, 0), a2, voffA);
            PG8_WAIT_V(8); PG8_WAIT_L(0); PG8_BAR; PG8_MMA(1, 0, At, B0); PG8_MMA(1, 1, At, B1); PG8_BAR; PG8_SCHED;
            PG8_LDB(B0, 1, 0); PG8_LDB(B1, 1, 1); PG8_SCHED; PG8_LDA(At, 1, 0); PG8_STAGE(PG8_SA(0, 1), a2 + hstep, voffA);
            PG8_WAIT_V(8); PG8_WAIT_L(0); PG8_BAR; PG8_MMA(0, 0, At, B0); PG8_MMA(0, 1, At, B1); PG8_BAR; PG8_SCHED;
            PG8_LDA(At, 1, 1); PG8_STAGE(PG8_SB(1, 0), b3, voffB); PG8_STAGE(PG8_SB(1, 1), b3 + hstep, voffB); PG8_STAGE(PG8_SA(1, 0), a3, voffA);
            PG8_WAIT_V(8); PG8_WAIT_L(0); PG8_BAR; PG8_MMA(1, 0, At, B0); PG8_MMA(1, 1, At, B1); PG8_BAR; PG8_SCHED;
            } else {
            PG8_LDB(B0, 0, 0); PG8_SCHED; PG8_LDA(At, 0, 0); PG8_STAGE(PG8_SA(1, 1), a1 + hstep, voffA);
            PG8_WAIT_L(8); PG8_BAR; PG8_WAIT_L(0); PG8_MMA(0, 0, At, B0); PG8_BAR; PG8_SCHED;
            PG8_LDB(B1, 0, 1); PG8_STAGE(PG8_SB(0, 0), b2, voffB);
            PG8_BAR; PG8_WAIT_L(0); PG8_MMA(0, 1, At, B1); PG8_BAR;
            PG8_LDA(At, 0, 1); PG8_STAGE(PG8_SA(0, 0), a2, voffA);
            PG8_BAR; PG8_WAIT_L(0); PG8_MMA(1, 0, At, B0); PG8_BAR; PG8_SCHED;
            PG8_STAGE(PG8_SB(0, 1), b2 + hstep, voffB);
            PG8_WAIT_V(6); PG8_BAR; PG8_MMA(1, 1, At, B1); PG8_BAR;
            PG8_LDB(B0, 1, 0); PG8_SCHED; PG8_LDA(At, 1, 0); PG8_STAGE(PG8_SA(0, 1), a2 + hstep, voffA);
            PG8_WAIT_L(8); PG8_BAR; PG8_WAIT_L(0); PG8_MMA(0, 0, At, B0); PG8_BAR; PG8_SCHED;
            PG8_LDB(B1, 1, 1); PG8_STAGE(PG8_SB(1, 0), b3, voffB);
            PG8_BAR; PG8_WAIT_L(0); PG8_MMA(0, 1, At, B1); PG8_BAR;
            PG8_LDA(At, 1, 1); PG8_STAGE(PG8_SA(1, 0), a3, voffA);
            PG8_BAR; PG8_WAIT_L(0); PG8_MMA(1, 0, At, B0); PG8_BAR; PG8_SCHED;
            PG8_STAGE(PG8_SB(1, 1), b3 + hstep, voffB);
            PG8_WAIT_V(6); PG8_BAR; PG8_MMA(1, 1, At, B1); PG8_BAR;
            }
        }
        if constexpr (ALIGN_EPI) { if (wr == 0) PG8_BAR; }
        if constexpr (!Epi::AFTER_DRAIN) { E(acc, cur, wr, wc, fr, fq, epf); S.done(cur); }
        if (!has_next) break;
#pragma unroll
        for (int a = 0; a < 2; ++a)
#pragma unroll
            for (int b = 0; b < 2; ++b)
#pragma unroll
                for (int m = 0; m < 4; ++m)
#pragma unroll
                    for (int n = 0; n < 2; ++n) acc[a][b][m][n] = (f32x4){0.f, 0.f, 0.f, 0.f};
        cur = nxt; cA = nA; cB = nB; ++ui;
        E.pre(cur, wr, fr, epf);
        if constexpr (ALIGN_EPI) { if (wr == 1) PG8_BAR; }
    }
    PG8_WAIT_V(0);
    if constexpr (!ALIGN_EPI) { if (wr == 0) PG8_BAR; }
    PG8_BAR;
    if constexpr (Epi::AFTER_DRAIN) { E.fused(acc, cur, wr, wc, fr, fq, lds, wid, lane); S.done(cur); }
#undef PG8_SA
#undef PG8_SB
#undef PG8_STAGE
#undef PG8_LDA
#undef PG8_LDB
#undef PG8_MMA
#undef PG8_WAIT_V
#undef PG8_WAIT_L
#undef PG8_BAR
#undef PG8_SCHED
}
}

#define LAS __attribute__((address_space(3)))
typedef LAS unsigned char* ldsp;
typedef unsigned short bf16;
typedef short bf16x8 __attribute__((ext_vector_type(8)));
typedef float f32x4 __attribute__((ext_vector_type(4)));
typedef float f32x16 __attribute__((ext_vector_type(16)));
typedef unsigned u32x4 __attribute__((ext_vector_type(4)));
typedef unsigned u32x2 __attribute__((ext_vector_type(2)));
typedef float f32x2_t __attribute__((ext_vector_type(2)));
typedef __bf16 bf16x2_t __attribute__((ext_vector_type(2)));

constexpr int NBATCH = 4, L = 8192, M = NBATCH * L, D = 1024, FF = 2816, NUP = 2 * FF, NP = 3840, NPG = 3584, NLAYER = 2;
constexpr float EPS = 1e-6f, LOG2E = 1.4426950408889634f;
constexpr int PC_AQ = 0, PC_AK = 256, PC_AV = 512, PC_AG = 768, PC_BQ = 1024, PC_BK = 1280, PC_BV = 1536, PC_CZ = 1792, PC_XBC = 2048,
              PC_DB = 2816, PC_DC = 3072, PC_DV = 3328, PC_ALR = 3584, PC_BF = 3600, PC_DT = 3604;
constexpr size_t MiB = 1u << 20;
constexpr size_t WS_W = 1 * MiB, W_LSTRIDE = 42 * MiB + 512 * 1024;
constexpr size_t WO_1U = 0, WO_1D = 11 * MiB, WO_IN = 16 * MiB + 512 * 1024, WO_OUT = 24 * MiB, WO_2U = 26 * MiB, WO_2D = 37 * MiB;
constexpr size_t WS_RS = 489 * MiB;
constexpr size_t WS_XN = 86 * MiB;
constexpr size_t WS_HP = 150 * MiB;
constexpr size_t WS_XG2 = WS_HP + 176 * MiB;
constexpr size_t WS_VT = 390 * MiB;
constexpr size_t WS_GST = 406 * MiB;
constexpr size_t WS_GD = 438 * MiB;
constexpr size_t WS_SST = 439 * MiB;
constexpr size_t WS_SD = 471 * MiB;
constexpr size_t WS_FRAW = 471 * MiB + 65536;
constexpr size_t WS_FL = 472 * MiB;
constexpr size_t WS_XS = 473 * MiB;
constexpr size_t WS_END = 491 * MiB;
constexpr int LDS_BYTES = 150 * 1024;
constexpr int NTHREADS = 512;

template <class T> __device__ __forceinline__ T lds_ld(ldsp p, int off) { return *(const LAS T*)(p + off); }
template <class T> __device__ __forceinline__ void lds_st(ldsp p, int off, T v) { *(LAS T*)(p + off) = v; }
__device__ __forceinline__ ldsp lds_opaque(ldsp p) { unsigned a = (unsigned)(size_t)p; asm volatile("" : "+v"(a)); return (ldsp)(size_t)a; }
__device__ __forceinline__ float bf2f(bf16 u) { return __uint_as_float((unsigned)u << 16); }
__device__ __forceinline__ unsigned pk2(float lo, float hi) { f32x2_t v = {lo, hi}; bf16x2_t b = __builtin_convertvector(v, bf16x2_t); return __builtin_bit_cast(unsigned, b); }
__device__ __forceinline__ bf16 f2bf(float f) { return (bf16)(pk2(f, 0.f) & 0xffffu); }
__device__ __forceinline__ float lo16(unsigned w) { return __uint_as_float(w << 16); }
__device__ __forceinline__ float hi16(unsigned w) { return __uint_as_float(w & 0xffff0000u); }
__device__ __forceinline__ bf16x8 pack8(float a0, float a1, float a2, float a3, float a4, float a5, float a6, float a7) {
    u32x4 w; w.x = pk2(a0, a1); w.y = pk2(a2, a3); w.z = pk2(a4, a5); w.w = pk2(a6, a7); return __builtin_bit_cast(bf16x8, w); }
__device__ __forceinline__ bf16x8 cat2(u32x2 a, u32x2 b) { u32x4 w; w.x = a.x; w.y = a.y; w.z = b.x; w.w = b.y; return __builtin_bit_cast(bf16x8, w); }
__device__ __forceinline__ float silu(float x) { return x / (1.0f + __expf(-x)); }
__device__ __forceinline__ float logsigmoid(float x) { return fminf(x, 0.f) - log1pf(__expf(-fabsf(x))); }
__device__ __forceinline__ float softplus(float x) { return fmaxf(x, 0.f) + log1pf(__expf(-fabsf(x))); }
__device__ __forceinline__ int crow(int r, int hi) { return (r & 3) + 8 * (r >> 2) + 4 * hi; }
#define MFMA32(a, b, c) __builtin_amdgcn_mfma_f32_32x32x16_bf16((a), (b), (c), 0, 0, 0)
__device__ __forceinline__ void unpack8(u32x4 w, float (&o)[8]) { o[0] = lo16(w.x); o[1] = hi16(w.x); o[2] = lo16(w.y); o[3] = hi16(w.y); o[4] = lo16(w.z); o[5] = hi16(w.z); o[6] = lo16(w.w); o[7] = hi16(w.w); }

struct Ctx {
    unsigned char* ws;
    ldsp lds; int tid, lane, wave, nblk, blk;
};

__device__ __forceinline__ Ctx relaunder(const Ctx& C0) { Ctx C = C0; int t = C0.tid; asm volatile("" : "+v"(t)); C.tid = t; C.lane = t & 63; C.wave = __builtin_amdgcn_readfirstlane(t >> 6); return C; }

__device__ __forceinline__ int win_src_col(int j) {
    if (j < 1024) return j;
    if (j < 1792) return j + 16;
    if (j < 2816) return j + 20;
    if (j < 3584) return j + 24;
    if (j < 3600) return 1024 + (j - 3584);
    if (j < 3604) return 1808 + (j - 3600);
    if (j < 3608) return 2836 + (j - 3604);
    return -1;
}
__device__ __forceinline__ void wt_item(int kind, const float* W0, const float* W1, const float* gsc, int K, int Nsrc, int Ndst, bf16* WT, ldsp scr, int item, int lane) {
    const int nblk = Ndst / 32, kb = item / nblk, nb = item % nblk, k0 = 64 * kb, n0 = 32 * nb;
    const int nd = n0 + (lane & 31);
    const float* src = W0; int col = nd;
    if (kind == 1) { const int pn = nd >> 8, bj = (nd >> 7) & 1, cc = nd & 127; src = bj ? W1 : W0; col = pn * 128 + cc; }
    else if (kind == 2) { col = win_src_col(nd); }
    float vv[32];
#pragma unroll
    for (int i = 0; i < 32; ++i) { const int kk = 2 * i + (lane >> 5); vv[i] = (col >= 0) ? src[(size_t)(k0 + kk) * Nsrc + col] : 0.f; }
    float gs = 1.f; const float* gp = gsc ? gsc + k0 + (lane >> 5) : nullptr;
#pragma unroll
    for (int i = 0; i < 32; ++i) { const int kk = 2 * i + (lane >> 5); if (gp) gs = gp[2 * i]; lds_st<float>(scr, (kk * 33 + (lane & 31)) * 4, vv[i] * gs); }
    asm volatile("s_waitcnt lgkmcnt(0)" ::: "memory");
    const int c = lane & 7;
#pragma unroll
    for (int j = 0; j < 4; ++j) { const int n = (lane >> 3) + 8 * j; const int so = ((8 * c) * 33 + n) * 4;
        u32x4 o; o.x = pk2(lds_ld<float>(scr, so), lds_ld<float>(scr, so + 33 * 4)); o.y = pk2(lds_ld<float>(scr, so + 2 * 33 * 4), lds_ld<float>(scr, so + 3 * 33 * 4));
        o.z = pk2(lds_ld<float>(scr, so + 4 * 33 * 4), lds_ld<float>(scr, so + 5 * 33 * 4)); o.w = pk2(lds_ld<float>(scr, so + 6 * 33 * 4), lds_ld<float>(scr, so + 7 * 33 * 4));
        *(u32x4*)(WT + (size_t)(n0 + n) * K + k0 + 8 * c) = o; }
    asm volatile("s_waitcnt lgkmcnt(0)" ::: "memory");
}
struct Args { const float* in[27]; float* out; unsigned char* ws; int ph_lo, ph_hi; };
__device__ __forceinline__ const float* in_ptr(const Args& a, int k) { asm volatile("" : "+s"(k)); return a.in[k]; }
__device__ __forceinline__ void prologue(const Ctx& C, const Args& A) {
    ldsp scr = C.lds + C.wave * 8448;
    const int gw = C.blk * 8 + C.wave, NGW = C.nblk * 8;
    constexpr int I_U = 16 * (NUP / 32), I_D = (FF / 64) * 32, I_IN = 16 * (NP / 32), I_O = 16 * 32, I_L = 2 * I_U + 2 * I_D + I_IN + I_O;
    for (int it = gw; it < NLAYER * I_L; it += NGW) {
        const int l = it / I_L; int r = it % I_L;
        unsigned char* wb = C.ws + WS_W + (size_t)l * W_LSTRIDE;
        const size_t o_gu = (size_t)l * D * FF, o_dn = (size_t)l * FF * D;
        if (r < I_U) { wt_item(1, in_ptr(A, 2) + o_gu, in_ptr(A, 3) + o_gu, in_ptr(A, 1) + l * D, D, FF, NUP, (bf16*)(wb + WO_1U), scr, r, C.lane); continue; } r -= I_U;
        if (r < I_D) { wt_item(0, in_ptr(A, 4) + o_dn, nullptr, nullptr, FF, D, D, (bf16*)(wb + WO_1D), scr, r, C.lane); continue; } r -= I_D;
        if (r < I_IN) { wt_item(2, in_ptr(A, 6) + (size_t)l * D * 3608, nullptr, in_ptr(A, 5) + l * D, D, 3608, NP, (bf16*)(wb + WO_IN), scr, r, C.lane); continue; } r -= I_IN;
        if (r < I_O) { wt_item(0, in_ptr(A, 22) + (size_t)l * D * D, nullptr, nullptr, D, D, D, (bf16*)(wb + WO_OUT), scr, r, C.lane); continue; } r -= I_O;
        if (r < I_U) { wt_item(1, in_ptr(A, 24) + o_gu, in_ptr(A, 25) + o_gu, in_ptr(A, 23) + l * D, D, FF, NUP, (bf16*)(wb + WO_2U), scr, r, C.lane); continue; } r -= I_U;
        wt_item(0, in_ptr(A, 26) + o_dn, nullptr, nullptr, FF, D, D, (bf16*)(wb + WO_2D), scr, r, C.lane);
    }
}
__device__ __forceinline__ float wave_sum(float v) {
#pragma unroll
    for (int o = 1; o < 64; o <<= 1) v += __shfl_xor(v, o);
    return v;
}
__device__ __forceinline__ void norm_phase(const Ctx& C, const float* x, bf16* xb, unsigned long long* rs) {
    const int gw = C.blk * 8 + C.wave, NGW = C.nblk * 8;
    for (int m = 4 * gw; m < M; m += 4 * NGW) {
        f32x4 v[4][4];
#pragma unroll
        for (int q = 0; q < 4; ++q) { const f32x4* xr = (const f32x4*)(x + (size_t)(m + q) * D) + C.lane;
#pragma unroll
            for (int j = 0; j < 4; ++j) v[q][j] = xr[64 * j]; }
#pragma unroll
        for (int q = 0; q < 4; ++q) { u32x2* o8 = (u32x2*)(xb + (size_t)(m + q) * D) + C.lane; float s = 0.f;
#pragma unroll
            for (int j = 0; j < 4; ++j) { const f32x4 t = v[q][j]; u32x2 w; w.x = pk2(t.x, t.y); w.y = pk2(t.z, t.w); o8[64 * j] = w;
                const float r0 = lo16(w.x), r1 = hi16(w.x), r2 = lo16(w.y), r3 = hi16(w.y); s += (r0 * r0 + r1 * r1) + (r2 * r2 + r3 * r3); }
            s = wave_sum(s);
            if (C.lane == 0) rs[m + q] = (unsigned long long)(s * 1048576.0f + 0.5f); }
    }
}
#define XB_TMO      128
#define XB_XCNT(j)  (256  + 64 * (j))
#define XB_XSUB(j)  (1280 + 64 * (j))
#define XB_XGEN(j)  (2304 + 64 * (j))
#define XB_TOP      3328
#define XB_TOPGEN   3392
#define XCD_BAR_WORDS 3456
#define XB_SPIN_CAP (1u << 18)

__device__ __forceinline__ unsigned xb_ld(unsigned* p)              { return __hip_atomic_load(p, __ATOMIC_RELAXED, __HIP_MEMORY_SCOPE_AGENT); }
__device__ __forceinline__ unsigned xb_add(unsigned* p, unsigned v) { return __hip_atomic_fetch_add(p, v, __ATOMIC_RELAXED, __HIP_MEMORY_SCOPE_AGENT); }
__device__ __forceinline__ unsigned xb_xcc_id() { return (unsigned)__builtin_amdgcn_s_getreg((3 << 11) | 20) & 0xFu; }
#define XB_SPIN(cond, bar) do { unsigned _sp = 0; while (cond) { __builtin_amdgcn_s_sleep(1); \
    if ((++_sp & 255u) == 0u) { if (xb_ld(&(bar)[XB_TMO])) break; if (_sp > XB_SPIN_CAP) { atomicAdd(&(bar)[XB_TMO], 1u); break; } } } } while (0)

struct XcdBarrier {
    unsigned* bar; unsigned x;
    volatile LAS unsigned* st;
};

__device__ __forceinline__ XcdBarrier xcd_barrier_post(unsigned* bar, volatile LAS unsigned* st) {
    XcdBarrier b; b.bar = bar; b.x = xb_xcc_id(); b.st = st;
    if (threadIdx.x == 0) (void)xb_add(&bar[XB_XCNT(b.x)], 1u);
    return b;
}
__device__ __forceinline__ void xcd_barrier_complete(unsigned* bar, unsigned x, unsigned& nloc, unsigned& nx) {
    const unsigned G = gridDim.x * gridDim.y * gridDim.z;
    unsigned sum, cnt, mine, sp = 0u;
    for (;;) {
        sum = 0u; cnt = 0u; mine = 0u;
#pragma unroll
        for (unsigned j = 0; j < 16; ++j) { const unsigned c = xb_ld(&bar[XB_XCNT(j)]); sum += c; cnt += (c > 0u) ? 1u : 0u; mine = (j == x) ? c : mine; }
        if (sum == G) break;
        __builtin_amdgcn_s_sleep(1);
        if ((++sp & 255u) == 0u) { if (xb_ld(&bar[XB_TMO])) break; if (sp > XB_SPIN_CAP) { atomicAdd(&bar[XB_TMO], 1u); break; } }
    }
    nloc = mine > 0u ? mine : 1u; nx = cnt > 0u ? cnt : 1u;
}

__device__ __forceinline__ void xcd_barrier(const XcdBarrier& b) {
    asm volatile("s_waitcnt vmcnt(0)" ::: "memory");
    __syncthreads();
    if (threadIdx.x == 0) {
        unsigned* bar = b.bar;
        __builtin_amdgcn_s_waitcnt(0);
        unsigned nloc = b.st[0], nx = b.st[1];
        if (nloc == 0u) { xcd_barrier_complete(bar, b.x, nloc, nx); b.st[0] = nloc; b.st[1] = nx; }
        const unsigned old = xb_add(&bar[XB_XSUB(b.x)], 1u);
        const unsigned gen = old / nloc;
        if (old + 1u == (gen + 1u) * nloc) {
            __builtin_amdgcn_fence(__ATOMIC_RELEASE, "agent");
            asm volatile("s_waitcnt vmcnt(0)" ::: "memory");
            const unsigned og = xb_add(&bar[XB_TOP], 1u);
            const unsigned tg = og / nx;
            if (og + 1u == (tg + 1u) * nx) xb_add(&bar[XB_TOPGEN], 1u);
            else XB_SPIN(xb_ld(&bar[XB_TOPGEN]) == tg, bar);
            __builtin_amdgcn_fence(__ATOMIC_ACQUIRE, "agent");
            xb_add(&bar[XB_XGEN(b.x)], 1u);
            asm volatile("s_waitcnt vmcnt(0)" ::: "memory");
        } else {
            XB_SPIN(xb_ld(&bar[XB_XGEN(b.x)]) == gen, bar);
            __builtin_amdgcn_fence(__ATOMIC_ACQUIRE, "agent");
            asm volatile("s_waitcnt vmcnt(0)" ::: "memory");
        }
    }
    __syncthreads();
}

__device__ __forceinline__ void xcd_barrier_flatrel(const XcdBarrier& b, unsigned& kcount) {
    asm volatile("s_waitcnt vmcnt(0)" ::: "memory");
    __syncthreads();
    if (threadIdx.x == 0) {
        unsigned* bar = b.bar;
        __builtin_amdgcn_s_waitcnt(0);
        unsigned nloc = b.st[0], nx = b.st[1];
        if (nloc == 0u) { xcd_barrier_complete(bar, b.x, nloc, nx); b.st[0] = nloc; b.st[1] = nx; }
        const unsigned old = xb_add(&bar[XB_XSUB(b.x)], 1u);
        const unsigned gen = old / nloc;
        if (old + 1u == (gen + 1u) * nloc) {
            __builtin_amdgcn_fence(__ATOMIC_RELEASE, "agent");
            asm volatile("s_waitcnt vmcnt(0)" ::: "memory");
            const unsigned og = xb_add(&bar[XB_TOP], 1u);
            const unsigned tg = og / nx;
            if (og + 1u == (tg + 1u) * nx) xb_add(&bar[XB_TOPGEN], 1u);
        }
        const unsigned want = kcount + 1u;
        XB_SPIN(xb_ld(&bar[XB_TOPGEN]) < want, bar);
        __builtin_amdgcn_fence(__ATOMIC_ACQUIRE, "agent");
        asm volatile("s_waitcnt vmcnt(0)" ::: "memory");
    }
    __syncthreads();
    ++kcount;
}

constexpr int STG_ROW = 144, STG_BYTES = 32 * STG_ROW;
__device__ __forceinline__ void stage_write(ldsp st, const f32x16 (&o)[2], int r32, int hi) {
#pragma unroll
    for (int vt = 0; vt < 2; ++vt)
#pragma unroll
        for (int g = 0; g < 4; ++g) { u32x2 w; w.x = pk2(o[vt][4 * g], o[vt][4 * g + 1]); w.y = pk2(o[vt][4 * g + 2], o[vt][4 * g + 3]);
            lds_st<u32x2>(st, r32 * STG_ROW + (32 * vt + 8 * g + 4 * hi) * 2, w); }
}
__device__ __forceinline__ void load8f(const float* p, float (&o)[8]) { const f32x4 a = *(const f32x4*)p, b = *(const f32x4*)(p + 4); o[0] = a.x; o[1] = a.y; o[2] = a.z; o[3] = a.w; o[4] = b.x; o[5] = b.y; o[6] = b.z; o[7] = b.w; }
__device__ __forceinline__ bf16x8 ldg_f32_as_bf16x8(const float* p) { const f32x4 a = *(const f32x4*)p, b = *(const f32x4*)(p + 4); return pack8(a.x, a.y, a.z, a.w, b.x, b.y, b.z, b.w); }
__device__ __forceinline__ u32x4 pack8u(const float (&v)[8]) { u32x4 w; w.x = pk2(v[0], v[1]); w.y = pk2(v[2], v[3]); w.z = pk2(v[4], v[5]); w.w = pk2(v[6], v[7]); return w; }


__device__ __forceinline__ void small_gates_unit(const Ctx& C0, const bf16* Xb, const bf16* Wt, const unsigned long long* rs, bf16* P, int unit) {
    const Ctx C = relaunder(C0);
    typedef float f32x4v __attribute__((ext_vector_type(4)));
    const int r16 = C.lane & 15, kq = C.lane >> 4, m0 = 16 * unit;
    const bf16* ap = Wt + (size_t)(NPG + r16) * D + 8 * kq; const bf16* bp = Xb + (size_t)(m0 + r16) * D + 8 * kq;
    f32x4v acc0 = (f32x4v){0.f, 0.f, 0.f, 0.f}, acc1 = acc0;
#pragma unroll 1
    for (int half = 0; half < 2; ++half) {
        bf16x8 a0[16], a1[16], bb[16];
#pragma unroll
        for (int s = 0; s < 16; ++s) { const int ko = 32 * (16 * half + s); a0[s] = *(const bf16x8*)(ap + ko); a1[s] = *(const bf16x8*)(ap + (size_t)16 * D + ko); bb[s] = *(const bf16x8*)(bp + ko); }
#pragma unroll
        for (int s = 0; s < 16; ++s) { acc0 = __builtin_amdgcn_mfma_f32_16x16x32_bf16(a0[s], bb[s], acc0, 0, 0, 0); acc1 = __builtin_amdgcn_mfma_f32_16x16x32_bf16(a1[s], bb[s], acc1, 0, 0, 0); }
    }
    const float rstd = rsqrtf((float)rs[m0 + r16] * (1.0f / 1048576.0f) * (1.0f / 1024.0f) + EPS);
    bf16* o = P + (size_t)(m0 + r16) * NP + NPG + 4 * kq;
    { u32x2 w; w.x = pk2(acc0[0] * rstd, acc0[1] * rstd); w.y = pk2(acc0[2] * rstd, acc0[3] * rstd); *(u32x2*)o = w; }
    if (kq < 2) { u32x2 w; w.x = pk2(acc1[0] * rstd, acc1[1] * rstd); w.y = pk2(acc1[2] * rstd, acc1[3] * rstd); *(u32x2*)(o + 16) = w; }
}
__device__ __forceinline__ f32x4 sc_cv(const bf16* P, int m, int c) {
    const u32x2 a = *(const u32x2*)(P + (size_t)m * NP + PC_DC + c), b = *(const u32x2*)(P + (size_t)m * NP + PC_DV + c);
    return (f32x4){lo16(a.x) * lo16(b.x), hi16(a.x) * hi16(b.x), lo16(a.y) * lo16(b.y), hi16(a.y) * hi16(b.y)};
}
__device__ __forceinline__ void sc_unit(const Ctx& C0, const bf16* P, bf16* Y, const float* cw, const float* gn, int wu) {
    const Ctx C = relaunder(C0);
    const int c = 4 * C.lane, m0 = 32 * wu, t0 = m0 & (L - 1);
    const f32x4 w0 = *(const f32x4*)(cw + c), w1 = *(const f32x4*)(cw + 256 + c), w2 = *(const f32x4*)(cw + 512 + c), g = *(const f32x4*)(gn + c);
    f32x4 p2 = (f32x4){0.f, 0.f, 0.f, 0.f}, p1 = p2;
    if (t0 > 0) { p2 = sc_cv(P, m0 - 2, c); p1 = sc_cv(P, m0 - 1, c); }
    for (int i = 0; i < 32; ++i) {
        const int m = m0 + i; const f32x4 cv = sc_cv(P, m, c);
        const u32x2 bb = *(const u32x2*)(P + (size_t)m * NP + PC_DB + c);
        const f32x4 bg = (f32x4){lo16(bb.x), hi16(bb.x), lo16(bb.y), hi16(bb.y)};
        const f32x4 y = bg * (w0 * p2 + w1 * p1 + w2 * cv);
        float ss = (y.x * y.x + y.y * y.y) + (y.z * y.z + y.w * y.w);
        ss += __shfl_xor(ss, 1); ss += __shfl_xor(ss, 2); ss += __shfl_xor(ss, 4); ss += __shfl_xor(ss, 8);
        const float rstd = rsqrtf(ss * (1.f / 64.f) + EPS);
        u32x2 w; w.x = pk2(y.x * rstd * g.x, y.y * rstd * g.y); w.y = pk2(y.z * rstd * g.z, y.w * rstd * g.w);
        *(u32x2*)(Y + (size_t)m * D + 768 + c) = w;
        p2 = p1; p1 = cv;
    }
}
__device__ __forceinline__ void foxprep_unit(const Ctx& C0, bf16* P, bf16* Vt, float* Fraw, const float* qn, const float* kn, const float* bfor, int wu) {
    const Ctx C = relaunder(C0);
    const int lane = C.lane, c = 4 * lane, h = lane >> 4, d = c & 63, m0 = 32 * wu, b = m0 / L, t0 = m0 & (L - 1);
    const f32x4 gq = *(const f32x4*)(qn + d), gk = *(const f32x4*)(kn + d);
    const float C2 = 0.125f * LOG2E;
    for (int i8 = 0; i8 < 4; ++i8) {
        u32x2 vraw[8];
#pragma unroll
        for (int j = 0; j < 8; ++j) {
            const size_t ro = (size_t)(m0 + 8 * i8 + j) * NP;
            const u32x2 qa = *(const u32x2*)(P + ro + PC_BQ + c), ka = *(const u32x2*)(P + ro + PC_BK + c); vraw[j] = *(const u32x2*)(P + ro + PC_BV + c);
            const f32x4 q = (f32x4){lo16(qa.x), hi16(qa.x), lo16(qa.y), hi16(qa.y)}, k = (f32x4){lo16(ka.x), hi16(ka.x), lo16(ka.y), hi16(ka.y)};
            float sq = (q.x * q.x + q.y * q.y) + (q.z * q.z + q.w * q.w), sk = (k.x * k.x + k.y * k.y) + (k.z * k.z + k.w * k.w);
            sq += __shfl_xor(sq, 1); sk += __shfl_xor(sk, 1); sq += __shfl_xor(sq, 2); sk += __shfl_xor(sk, 2);
            sq += __shfl_xor(sq, 4); sk += __shfl_xor(sk, 4); sq += __shfl_xor(sq, 8); sk += __shfl_xor(sk, 8);
            const float rq = rsqrtf(sq * (1.f / 64.f) + EPS) * C2, rk = rsqrtf(sk * (1.f / 64.f) + EPS);
            u32x2 wq, wk; wq.x = pk2(q.x * rq * gq.x, q.y * rq * gq.y); wq.y = pk2(q.z * rq * gq.z, q.w * rq * gq.w);
            wk.x = pk2(k.x * rk * gk.x, k.y * rk * gk.y); wk.y = pk2(k.z * rk * gk.z, k.w * rk * gk.w);
            *(u32x2*)(P + ro + PC_BQ + c) = wq; *(u32x2*)(P + ro + PC_BK + c) = wk;
        }
        bf16* vrow = Vt + ((size_t)((b * 4 + h) * 64 + d)) * L + t0 + 8 * i8;
        u32x4 e0, e1, e2, e3;
#define FP_LO(a, b) (((a) & 0xffffu) | ((b) << 16))
#define FP_HI(a, b) (((a) >> 16) | ((b) & 0xffff0000u))
        e0.x = FP_LO(vraw[0].x, vraw[1].x); e0.y = FP_LO(vraw[2].x, vraw[3].x); e0.z = FP_LO(vraw[4].x, vraw[5].x); e0.w = FP_LO(vraw[6].x, vraw[7].x);
        e1.x = FP_HI(vraw[0].x, vraw[1].x); e1.y = FP_HI(vraw[2].x, vraw[3].x); e1.z = FP_HI(vraw[4].x, vraw[5].x); e1.w = FP_HI(vraw[6].x, vraw[7].x);
        e2.x = FP_LO(vraw[0].y, vraw[1].y); e2.y = FP_LO(vraw[2].y, vraw[3].y); e2.z = FP_LO(vraw[4].y, vraw[5].y); e2.w = FP_LO(vraw[6].y, vraw[7].y);
        e3.x = FP_HI(vraw[0].y, vraw[1].y); e3.y = FP_HI(vraw[2].y, vraw[3].y); e3.z = FP_HI(vraw[4].y, vraw[5].y); e3.w = FP_HI(vraw[6].y, vraw[7].y);
#undef FP_LO
#undef FP_HI
        *(u32x4*)(vrow) = e0; *(u32x4*)(vrow + L) = e1; *(u32x4*)(vrow + 2 * L) = e2; *(u32x4*)(vrow + 3 * L) = e3;
        if (lane < 32) { const int j = lane >> 2, hh = lane & 3; const int m = m0 + 8 * i8 + j;
            const float f = bf2f(P[(size_t)m * NP + PC_BF + hh]) + bfor[hh];
            Fraw[(size_t)(b * 4 + hh) * L + t0 + 8 * i8 + j] = logsigmoid(f); }
    }
}

constexpr int G_QD = 0, G_KD = 33792, G_VT = 67584, G_GLR = 104448, G_TOT = 108544, G_STG = 110592;
constexpr int GROW = 528, TROW = 144;
__device__ __forceinline__ float gla_la(ldsp GLR, int t, const float (&w2)[16], float bg) {
    float z = bg;
#pragma unroll
    for (int r4 = 0; r4 < 4; ++r4) { const f32x4 gl = lds_ld<f32x4>(GLR, (t * 16 + r4 * 4) * 4); z += gl.x * w2[4 * r4] + gl.y * w2[4 * r4 + 1] + gl.z * w2[4 * r4 + 2] + gl.w * w2[4 * r4 + 3]; }
    const float ls = fminf(z, 0.f) - __logf(1.0f + __expf(-fabsf(z)));
    return ls * (1.f / 16.f);
}
__device__ __forceinline__ void gla_gate(const Ctx& C, ldsp GLR, ldsp TOT, const bf16* P, const float* w2g, const float* bgate, int m0, int c, int th, float (&bb)[32], float& blast) {
    for (int e = C.tid; e < 1024; e += NTHREADS) { const int t = e >> 4, r = e & 15; lds_st<float>(GLR, e * 4, bf2f(P[(size_t)(m0 + t) * NP + PC_ALR + r])); }
    float w2[16];
#pragma unroll
    for (int r = 0; r < 16; ++r) w2[r] = w2g[r * 256 + c];
    const float bg = bgate[c];
    __syncthreads();
    float run = 0.f;
#pragma unroll
    for (int i = 0; i < 32; ++i) { run += gla_la(GLR, 32 * th + i, w2, bg); bb[i] = run; if (i & 1) __builtin_amdgcn_sched_barrier(0); }
    lds_st<float>(TOT, (th * 256 + c) * 4, run);
    __syncthreads();
    const float t0 = lds_ld<float>(TOT, c * 4), t1 = lds_ld<float>(TOT, (256 + c) * 4);
    if (th) {
#pragma unroll
        for (int i = 0; i < 32; ++i) bb[i] += t0;
    }
    blast = t0 + t1;
}
__device__ __forceinline__ void gla_passA(const Ctx& C0, const bf16* P, float* GST, float* GD, const float* w2g, const float* bgate, int unit) {
    const Ctx C = relaunder(C0);
    const int b = unit >> 7, n = unit & 127, m0 = b * L + 64 * n, c = C.tid & 255, th = C.tid >> 8;
    __syncthreads();
    const ldsp QD = lds_opaque(C.lds + G_QD), KD = lds_opaque(C.lds + G_KD), VT_ = lds_opaque(C.lds + G_VT), GLR = lds_opaque(C.lds + G_GLR), TOT = lds_opaque(C.lds + G_TOT);
    bf16 rk[32], rv[32];
#pragma unroll
    for (int i = 0; i < 32; ++i) { const size_t ro = (size_t)(m0 + 32 * th + i) * NP; rk[i] = P[ro + PC_AK + c]; rv[i] = P[ro + PC_AV + c]; }
    float bb[32], blast; gla_gate(C, GLR, TOT, P, w2g, bgate, m0, c, th, bb, blast);
#pragma unroll
    for (int i8 = 0; i8 < 4; ++i8) { float kk[8], vv[8];
#pragma unroll
        for (int j = 0; j < 8; ++j) { kk[j] = bf2f(rk[8 * i8 + j]) * __expf(blast - bb[8 * i8 + j]); vv[j] = bf2f(rv[8 * i8 + j]); }
        lds_st<u32x4>(QD, c * TROW + (32 * th + 8 * i8) * 2, pack8u(kk)); lds_st<u32x4>(VT_, c * TROW + (32 * th + 8 * i8) * 2, pack8u(vv)); }
    if (th == 0) GD[(size_t)((b * 128 + n) * 4 + (c >> 6)) * 64 + (c & 63)] = __expf(blast);
    __syncthreads();
    const int w = C.wave, h = w >> 1, dt = w & 1, r32 = C.lane & 31, hi = C.lane >> 5;
    f32x16 acc[2]; acc[0] = (f32x16){}; acc[1] = (f32x16){};
#pragma unroll
    for (int s = 0; s < 4; ++s) { const bf16x8 bf = lds_ld<bf16x8>(QD, (h * 64 + 32 * dt + r32) * TROW + (16 * s + 8 * hi) * 2);
#pragma unroll
        for (int vt = 0; vt < 2; ++vt) { const bf16x8 af = lds_ld<bf16x8>(VT_, (h * 64 + 32 * vt + r32) * TROW + (16 * s + 8 * hi) * 2); acc[vt] = MFMA32(af, bf, acc[vt]); } }
    float* st = GST + (size_t)((b * 128 + n) * 4 + h) * 4096;
#pragma unroll
    for (int vt = 0; vt < 2; ++vt)
#pragma unroll
        for (int r = 0; r < 16; ++r) st[(32 * vt + crow(r, hi)) * 64 + 32 * dt + r32] = acc[vt][r];
}
__device__ __forceinline__ void gla_passC(const Ctx& C0, const bf16* P, const bf16* GSB, bf16* Y, const float* w2g, const float* bgate, const float* gnorm, int unit) {
    const Ctx C = relaunder(C0);
    const int b = unit >> 7, n = unit & 127, m0 = b * L + 64 * n, c = C.tid & 255, th = C.tid >> 8;
    __syncthreads();
    const ldsp QD = lds_opaque(C.lds + G_QD), KD = lds_opaque(C.lds + G_KD), VT_ = lds_opaque(C.lds + G_VT), GLR = lds_opaque(C.lds + G_GLR), TOT = lds_opaque(C.lds + G_TOT);
    bf16x8 sfr[2][4];
    { const int w_ = C.wave, h_ = w_ >> 1, r32_ = C.lane & 31, hi_ = C.lane >> 5; const bf16* stb = GSB + (size_t)((b * 128 + n) * 4 + h_) * 4096;
#pragma unroll
      for (int vt = 0; vt < 2; ++vt)
#pragma unroll
        for (int s_ = 0; s_ < 4; ++s_) sfr[vt][s_] = *(const bf16x8*)(stb + (32 * vt + r32_) * 64 + 16 * s_ + 8 * hi_); }
    { bf16 rq[32], rk[32], rv[32];
#pragma unroll
      for (int i = 0; i < 32; ++i) { const size_t ro = (size_t)(m0 + 32 * th + i) * NP; rq[i] = P[ro + PC_AQ + c]; rk[i] = P[ro + PC_AK + c]; rv[i] = P[ro + PC_AV + c]; }
      float bb[32], blast; gla_gate(C, GLR, TOT, P, w2g, bgate, m0, c, th, bb, blast);
#pragma unroll
      for (int i8 = 0; i8 < 4; ++i8) { float vv[8];
#pragma unroll
        for (int j = 0; j < 8; ++j) { const int t = 32 * th + 8 * i8 + j; const float e = __expf(bb[8 * i8 + j]), ei = __expf(-bb[8 * i8 + j]);
            const float q = bf2f(rq[8 * i8 + j]) * 0.125f * e, k = bf2f(rk[8 * i8 + j]) * ei; vv[j] = bf2f(rv[8 * i8 + j]);
            lds_st<bf16>(QD, t * GROW + c * 2, f2bf(q)); lds_st<bf16>(KD, t * GROW + c * 2, f2bf(k)); }
        lds_st<u32x4>(VT_, c * TROW + (32 * th + 8 * i8) * 2, pack8u(vv)); } }
    __syncthreads();
    const int w = C.wave, h = w >> 1, ih = w & 1, r32 = C.lane & 31, hi = C.lane >> 5;
    bf16x8 qf[4];
#pragma unroll
    for (int s = 0; s < 4; ++s) qf[s] = lds_ld<bf16x8>(QD, (32 * ih + r32) * GROW + (h * 64 + 16 * s + 8 * hi) * 2);
    f32x16 o[2]; o[0] = (f32x16){}; o[1] = (f32x16){};
    u32x4 gpre[4];
#pragma unroll
    for (int it = 0; it < 4; ++it) gpre[it] = *(const u32x4*)(P + (size_t)(m0 + 32 * ih + 8 * it + (C.lane >> 3)) * NP + PC_AG + h * 64 + 8 * (C.lane & 7));
#pragma unroll
    for (int vt = 0; vt < 2; ++vt)
#pragma unroll
        for (int s = 0; s < 4; ++s) o[vt] = MFMA32(sfr[vt][s], qf[s], o[vt]);
    for (int jt = 0; jt <= ih; ++jt) {
        f32x16 X = (f32x16){};
#pragma unroll
        for (int s = 0; s < 4; ++s) { const bf16x8 kf = lds_ld<bf16x8>(KD, (32 * jt + r32) * GROW + (h * 64 + 16 * s + 8 * hi) * 2); X = MFMA32(kf, qf[s], X); }
        if (jt == ih) {
#pragma unroll
            for (int r = 0; r < 16; ++r) if (crow(r, hi) > r32) X[r] = 0.f;
        }
#pragma unroll
        for (int s2 = 0; s2 < 2; ++s2) { const bf16x8 pf = pack8(X[8 * s2], X[8 * s2 + 1], X[8 * s2 + 2], X[8 * s2 + 3], X[8 * s2 + 4], X[8 * s2 + 5], X[8 * s2 + 6], X[8 * s2 + 7]);
#pragma unroll
            for (int vt = 0; vt < 2; ++vt) { const int ao = (h * 64 + 32 * vt + r32) * TROW + (32 * jt + 16 * s2 + 4 * hi) * 2;
                const bf16x8 af = cat2(lds_ld<u32x2>(VT_, ao), lds_ld<u32x2>(VT_, ao + 16)); o[vt] = MFMA32(af, pf, o[vt]); } }
    }
    ldsp stg = C.lds + G_STG + w * STG_BYTES;
    stage_write(stg, o, r32, hi);
    asm volatile("s_waitcnt lgkmcnt(0)" ::: "memory");
#pragma unroll
    for (int it = 0; it < 4; ++it) { const int row = 8 * it + (C.lane >> 3), ch = 8 * (C.lane & 7); const int m = m0 + 32 * ih + row;
        float y[8], gt[8], gn[8]; unpack8(lds_ld<u32x4>(stg, row * STG_ROW + ch * 2), y); unpack8(gpre[it], gt); load8f(gnorm + h * 64 + ch, gn);
        float ss = 0.f;
#pragma unroll
        for (int e = 0; e < 8; ++e) ss += y[e] * y[e];
        ss += __shfl_xor(ss, 1); ss += __shfl_xor(ss, 2); ss += __shfl_xor(ss, 4);
        const float rstd = rsqrtf(ss * (1.f / 64.f) + EPS);
#pragma unroll
        for (int e = 0; e < 8; ++e) y[e] = y[e] * rstd * gn[e] * silu(gt[e]);
        *(u32x4*)(Y + (size_t)m * D + h * 64 + ch) = pack8u(y); }
}

constexpr int S_B = 0, S_C = 34816, S_X = 69632, S_AS = 104448, S_DT = 105472, S_ACS = 106496, S_SSX = 107520, S_STG = 108544;
constexpr int SROW = 272;
__device__ __forceinline__ void ssd_dt(const Ctx& C, ldsp SM, const bf16* P, const float* dtb, const float* Alog, int m0, int g) {
    const int hh = (C.tid >> 7) & 1, j = C.tid & 127;
    if (C.tid < 256) { const int h = 2 * g + hh; const float dtv = softplus(bf2f(P[(size_t)(m0 + j) * NP + PC_DT + h]) + dtb[h]);
        lds_st<float>(SM, (S_DT - S_AS) + (hh * 128 + j) * 4, dtv); lds_st<float>(SM, (S_AS - S_AS) + (hh * 128 + j) * 4, -__expf(Alog[h]) * dtv); }
    __syncthreads();
    if (C.tid < 256) { float v = lds_ld<float>(SM, (S_AS - S_AS) + (hh * 128 + j) * 4);
#pragma unroll
        for (int o_ = 1; o_ < 64; o_ <<= 1) { const float t_ = __shfl_up(v, o_); if (C.lane >= o_) v += t_; }
        if ((j & 64) == 0 && C.lane == 63) lds_st<float>(SM, (S_SSX - S_AS) + hh * 4, v);
        lds_st<float>(SM, (S_ACS - S_AS) + (hh * 128 + j) * 4, v); }
    __syncthreads();
    if (C.tid < 256 && (j & 64)) lds_st<float>(SM, (S_ACS - S_AS) + (hh * 128 + j) * 4, lds_ld<float>(SM, (S_ACS - S_AS) + (hh * 128 + j) * 4) + lds_ld<float>(SM, (S_SSX - S_AS) + hh * 4));
    __syncthreads();
}
template <bool PASS_C>
__device__ __forceinline__ void ssd_issue(const Ctx& C, const bf16* P, int m0, int n, int g, bf16 (&rawa)[PASS_C ? 3 : 2][35]) {
    constexpr int NCH = PASS_C ? 384 : 256, NIT = PASS_C ? 3 : 2;
#pragma unroll
    for (int k = 0; k < NIT; ++k) {
        const int item = C.tid + NTHREADS * k, ch = item % NCH, tq = item / NCH, typ = ch >> 7, cc = ch & 127, ci = typ * 256 + g * 128 + cc, pcol = PC_XBC + ci, j0 = 32 * tq;
        const bf16* pp = P + ((ptrdiff_t)(m0 + j0) - 3) * NP + pcol; const bool hasprev = (128 * n + j0 > 0);
#pragma unroll
        for (int t_ = 0; t_ < 35; ++t_) rawa[k][t_] = (t_ >= 3 || hasprev) ? pp[(ptrdiff_t)t_ * NP] : (bf16)0;
    }
}
template <bool PASS_C>
__device__ __forceinline__ void ssd_load(const Ctx& C, ldsp SB, ldsp SC, ldsp SX, ldsp SM, const bf16 (&rawa)[PASS_C ? 3 : 2][35], bf16* XS, const float* cw, const float* cb, int m0, int n, int g) {
    constexpr int NCH = PASS_C ? 384 : 256, NIT = PASS_C ? 3 : 2;
#pragma unroll
    for (int k = 0; k < NIT; ++k) {
        const int item = C.tid + NTHREADS * k, ch = item % NCH, tq = item / NCH, typ = ch >> 7, cc = ch & 127, ci = typ * 256 + g * 128 + cc;
        const float w0 = cw[ci], w1 = cw[768 + ci], w2 = cw[1536 + ci], w3 = cw[2304 + ci], bias = cb[ci];
        const int j0 = 32 * tq, hh = cc >> 6;
        const bf16 (&raw)[35] = rawa[k];
        float u3 = bf2f(raw[0]), u2 = bf2f(raw[1]), u1 = bf2f(raw[2]);
        const float alast = lds_ld<float>(SM, (S_ACS - S_AS) + (hh * 128 + 127) * 4);
#pragma unroll
        for (int i8 = 0; i8 < 4; ++i8) { float yv[8];
#pragma unroll
            for (int j = 0; j < 8; ++j) { const float u0 = bf2f(raw[3 + 8 * i8 + j]);
                yv[j] = silu(w0 * u3 + w1 * u2 + w2 * u1 + w3 * u0 + bias); u3 = u2; u2 = u1; u1 = u0; }
            const int jb = j0 + 8 * i8;
            if (typ == 0) {
#pragma unroll
                for (int j = 0; j < 8; ++j) { const float dtv = lds_ld<float>(SM, (S_DT - S_AS) + (hh * 128 + jb + j) * 4);
                    if (!PASS_C) { XS[(size_t)(m0 + jb + j) * 256 + g * 128 + cc] = f2bf(yv[j]); yv[j] *= dtv * __expf(alast - lds_ld<float>(SM, (S_ACS - S_AS) + (hh * 128 + jb + j) * 4)); }
                    else yv[j] *= dtv; }
                lds_st<u32x4>(SX, cc * SROW + jb * 2, pack8u(yv));
            } else if (!PASS_C) { lds_st<u32x4>(SB, cc * SROW + jb * 2, pack8u(yv)); }
            else { const ldsp base = (typ == 1) ? SB : SC;
#pragma unroll
                for (int j = 0; j < 8; ++j) lds_st<bf16>(base, (jb + j) * SROW + cc * 2, f2bf(yv[j])); }
        }
    }
}
__device__ __forceinline__ void ssd_passA(const Ctx& C0, const bf16* P, bf16* XS, float* SST, float* SD, const float* cw, const float* cb, const float* dtb, const float* Alog, int unit) {
    const Ctx C = relaunder(C0);
    const int b = unit >> 7, n = (unit >> 1) & 63, g = unit & 1, m0 = b * L + 128 * n;
    __syncthreads();
    const ldsp SB = lds_opaque(C.lds + S_B), SC = lds_opaque(C.lds + S_C), SX = lds_opaque(C.lds + S_X), SM = lds_opaque(C.lds + S_AS);
    bf16 rawa[2][35]; ssd_issue<false>(C, P, m0, n, g, rawa);
    ssd_dt(C, SM, P, dtb, Alog, m0, g);
    ssd_load<false>(C, SB, SC, SX, SM, rawa, XS, cw, cb, m0, n, g);
    if (C.tid < 2) SD[(size_t)(b * 64 + n) * 4 + 2 * g + C.tid] = __expf(lds_ld<float>(SM, (S_ACS - S_AS) + (C.tid * 128 + 127) * 4));
    __syncthreads();
    const int w = C.wave, hh = w >> 2, nt = w & 3, r32 = C.lane & 31, hi = C.lane >> 5;
    f32x16 acc[2]; acc[0] = (f32x16){}; acc[1] = (f32x16){};
#pragma unroll
    for (int s = 0; s < 8; ++s) { const bf16x8 bf = lds_ld<bf16x8>(SB, (32 * nt + r32) * SROW + (16 * s + 8 * hi) * 2);
#pragma unroll
        for (int pt = 0; pt < 2; ++pt) { const bf16x8 af = lds_ld<bf16x8>(SX, (hh * 64 + 32 * pt + r32) * SROW + (16 * s + 8 * hi) * 2); acc[pt] = MFMA32(af, bf, acc[pt]); } }
    float* st = SST + (size_t)((b * 64 + n) * 4 + 2 * g + hh) * 8192;
#pragma unroll
    for (int pt = 0; pt < 2; ++pt)
#pragma unroll
        for (int r = 0; r < 16; ++r) st[(32 * pt + crow(r, hi)) * 128 + 32 * nt + r32] = acc[pt][r];
}
__device__ __forceinline__ void ssd_passC(const Ctx& C0, const bf16* P, const bf16* XS, const bf16* SSB, bf16* Y, const float* cw, const float* cb, const float* dtb, const float* Alog, const float* Dsk, const float* gnorm, int unit) {
    const Ctx C = relaunder(C0);
    const int b = unit >> 7, n = (unit >> 1) & 63, g = unit & 1, m0 = b * L + 128 * n;
    __syncthreads();
    const ldsp SB = lds_opaque(C.lds + S_B), SC = lds_opaque(C.lds + S_C), SX = lds_opaque(C.lds + S_X), SM = lds_opaque(C.lds + S_AS);
    bf16x8 sfr[2][8];
    { const int w_ = C.wave, hh_ = w_ >> 2, r32_ = C.lane & 31, hi_ = C.lane >> 5; const bf16* stb = SSB + (size_t)((b * 64 + n) * 4 + 2 * g + hh_) * 8192;
#pragma unroll
      for (int pt = 0; pt < 2; ++pt)
#pragma unroll
        for (int s_ = 0; s_ < 8; ++s_) sfr[pt][s_] = *(const bf16x8*)(stb + (32 * pt + r32_) * 128 + 16 * s_ + 8 * hi_); }
    bf16 rawa[3][35]; ssd_issue<true>(C, P, m0, n, g, rawa);
    ssd_dt(C, SM, P, dtb, Alog, m0, g);
    ssd_load<true>(C, SB, SC, SX, SM, rawa, nullptr, cw, cb, m0, n, g);
    __syncthreads();
    const int w = C.wave, hh = w >> 2, it = w & 3, r32 = C.lane & 31, hi = C.lane >> 5, h = 2 * g + hh;
    const float acs_i = lds_ld<float>(SM, (S_ACS - S_AS) + (hh * 128 + 32 * it + r32) * 4);
    f32x16 o[2]; o[0] = (f32x16){}; o[1] = (f32x16){};
    u32x4 xpre[4], zpre[4];
#pragma unroll
    for (int q4 = 0; q4 < 4; ++q4) { const int m_ = m0 + 32 * it + 8 * q4 + (C.lane >> 3); const int ch_ = 8 * (C.lane & 7);
        xpre[q4] = *(const u32x4*)(XS + (size_t)m_ * 256 + g * 128 + hh * 64 + ch_); zpre[q4] = *(const u32x4*)(P + (size_t)m_ * NP + PC_CZ + g * 128 + hh * 64 + ch_); }
#pragma unroll
    for (int s = 0; s < 8; ++s) { const bf16x8 cf = lds_ld<bf16x8>(SC, (32 * it + r32) * SROW + (16 * s + 8 * hi) * 2);
#pragma unroll
        for (int pt = 0; pt < 2; ++pt) o[pt] = MFMA32(sfr[pt][s], cf, o[pt]); }
    { const float ei = __expf(acs_i);
#pragma unroll
      for (int r = 0; r < 16; ++r) { o[0][r] *= ei; o[1][r] *= ei; } }
    for (int jt = 0; jt <= it; ++jt) {
        f32x16 X = (f32x16){};
#pragma unroll
        for (int s = 0; s < 8; ++s) { const bf16x8 bf = lds_ld<bf16x8>(SB, (32 * jt + r32) * SROW + (16 * s + 8 * hi) * 2);
            const bf16x8 cf = lds_ld<bf16x8>(SC, (32 * it + r32) * SROW + (16 * s + 8 * hi) * 2); X = MFMA32(bf, cf, X); }
#pragma unroll
        for (int r = 0; r < 16; ++r) { const int jl = 32 * jt + crow(r, hi); const float aj = lds_ld<float>(SM, (S_ACS - S_AS) + (hh * 128 + jl) * 4);
            X[r] = (jl <= 32 * it + r32) ? X[r] * __expf(acs_i - aj) : 0.f; }
#pragma unroll
        for (int s2 = 0; s2 < 2; ++s2) { const bf16x8 pf = pack8(X[8 * s2], X[8 * s2 + 1], X[8 * s2 + 2], X[8 * s2 + 3], X[8 * s2 + 4], X[8 * s2 + 5], X[8 * s2 + 6], X[8 * s2 + 7]);
#pragma unroll
            for (int pt = 0; pt < 2; ++pt) { const int ao = (hh * 64 + 32 * pt + r32) * SROW + (32 * jt + 16 * s2 + 4 * hi) * 2;
                const bf16x8 af = cat2(lds_ld<u32x2>(SX, ao), lds_ld<u32x2>(SX, ao + 16)); o[pt] = MFMA32(af, pf, o[pt]); } }
    }
    ldsp stg = C.lds + S_STG + w * STG_BYTES;
    stage_write(stg, o, r32, hi);
    asm volatile("s_waitcnt lgkmcnt(0)" ::: "memory");
    float yy[4][8]; const float Dh = Dsk[h]; const int ch = 8 * (C.lane & 7);
#pragma unroll
    for (int q4 = 0; q4 < 4; ++q4) { const int row = 8 * q4 + (C.lane >> 3); const int m = m0 + 32 * it + row;
        float xs[8], z[8]; unpack8(lds_ld<u32x4>(stg, row * STG_ROW + ch * 2), yy[q4]); unpack8(xpre[q4], xs); unpack8(zpre[q4], z);
        float ss = 0.f;
#pragma unroll
        for (int e = 0; e < 8; ++e) { yy[q4][e] = (yy[q4][e] + xs[e] * Dh) * silu(z[e]); ss += yy[q4][e] * yy[q4][e]; }
        ss += __shfl_xor(ss, 1); ss += __shfl_xor(ss, 2); ss += __shfl_xor(ss, 4);
        if ((C.lane & 7) == 0) lds_st<float>(SM, (S_SSX - S_AS) + ((hh * 4 + it) * 32 + row) * 4, ss); }
    __syncthreads();
    float gn[8]; load8f(gnorm + g * 128 + hh * 64 + ch, gn);
#pragma unroll
    for (int q4 = 0; q4 < 4; ++q4) { const int row = 8 * q4 + (C.lane >> 3); const int m = m0 + 32 * it + row;
        const float ss = lds_ld<float>(SM, (S_SSX - S_AS) + ((0 * 4 + it) * 32 + row) * 4) + lds_ld<float>(SM, (S_SSX - S_AS) + ((1 * 4 + it) * 32 + row) * 4);
        const float rstd = rsqrtf(ss * (1.f / 128.f) + EPS);
#pragma unroll
        for (int e = 0; e < 8; ++e) yy[q4][e] = yy[q4][e] * rstd * gn[e];
        *(u32x4*)(Y + (size_t)m * D + 512 + g * 128 + hh * 64 + ch) = pack8u(yy[q4]); }
}

constexpr int F_FS = 0, F_BUF = 32768, F_KROW = 144, F_VROW = 400, F_KB = 192 * F_KROW, F_BUFB = F_KB + 64 * F_VROW, F_STG = F_BUF, F_FLAG = F_BUF + 2 * F_BUFB;
__device__ __forceinline__ void fox_attn_unit(const Ctx& C0, const bf16* P, const bf16* Vt, const float* Fl, bf16* Y, const float* qn, const float* kn, const float* on, int unit) {
    const Ctx C = relaunder(C0);
    const int bh = unit >> 5, qb = unit & 31, b = bh >> 2, h = bh & 3, q0 = qb * 256, nk = q0 + 256, w = C.wave, r32 = C.lane & 31, hi = C.lane >> 5;
    __syncthreads();
    const float* Flg = Fl + (size_t)bh * L;
    { f32x4 fv[4];
#pragma unroll
      for (int k = 0; k < 4; ++k) { const int i = 4 * C.tid + 4 * NTHREADS * k; if (i < nk) fv[k] = *(const f32x4*)(Flg + i); }
#pragma unroll
      for (int k = 0; k < 4; ++k) { const int i = 4 * C.tid + 4 * NTHREADS * k; if (i < nk) lds_st<f32x4>(C.lds, F_FS + i * 4, fv[k]); } }
    float gm = fabsf(qn[C.lane]), km = fabsf(kn[C.lane]);
#pragma unroll
    for (int o_ = 1; o_ < 64; o_ <<= 1) { gm = fmaxf(gm, __shfl_xor(gm, o_)); km = fmaxf(km, __shfl_xor(km, o_)); }
    __syncthreads();
    const int q0w = q0 + 32 * w, ktlast = (q0w + 31) >> 6, ktlast_b = 4 * qb + 3;
    const float TH = 16.f * LOG2E * gm * km + 64.f;
    int lo, lo_b;
    { const float Fq0 = lds_ld<float>(C.lds, F_FS + q0w * 4); int a_ = 0, hb = ktlast;
      while (a_ < hb) { const int mid = (a_ + hb) >> 1; if (Fq0 - lds_ld<float>(C.lds, F_FS + (64 * mid + 63) * 4) >= -TH) hb = mid; else a_ = mid + 1; } lo = a_; }
    { const float Fq0 = lds_ld<float>(C.lds, F_FS + q0 * 4); int a_ = 0, hb = q0 >> 6;
      while (a_ < hb) { const int mid = (a_ + hb) >> 1; if (Fq0 - lds_ld<float>(C.lds, F_FS + (64 * mid + 63) * 4) >= -TH) hb = mid; else a_ = mid + 1; } lo_b = a_; }
    const float Flq = lds_ld<float>(C.lds, F_FS + (q0w + r32) * 4);
    const size_t mb = (size_t)b * L;
    bf16x8 qr[4];
#pragma unroll
    for (int d0 = 0; d0 < 4; ++d0) qr[d0] = *(const bf16x8*)(P + (mb + q0w + r32) * NP + PC_BQ + h * 64 + 16 * d0 + 8 * hi);
    float mrun = -INFINITY, lrun = 0.f; f32x16 o[2]; o[0] = (f32x16){}; o[1] = (f32x16){};
    const int qrow = q0w + r32;
    const int nch = (ktlast_b - lo_b + 3) / 3;
    u32x4 st[6];
    const bf16* kg = P + (mb + (C.tid >> 3)) * NP + PC_BK + h * 64 + (C.tid & 7) * 8;
    const int vd = C.tid / 24, vs = C.tid % 24;
    const ldsp BUF = lds_opaque(C.lds + F_BUF);
#define FOX_LOAD(c_) do { const int kt0_ = lo_b + 3 * (c_); \
        _Pragma("unroll") for (int i = 0; i < 3; ++i) { if (kt0_ + i <= ktlast_b) st[i] = *(const u32x4*)(kg + (size_t)(64 * (kt0_ + i)) * NP); } \
        _Pragma("unroll") for (int i = 0; i < 3; ++i) { const int p_ = C.tid + 512 * i, d_ = p_ / 24, sg_ = p_ % 24; if (kt0_ + (sg_ >> 3) <= ktlast_b) st[3 + i] = *(const u32x4*)(Vt + ((size_t)(bh * 64 + d_)) * L + 64 * kt0_ + sg_ * 8); } } while (0)
#define FOX_STORE(c_, par_) do { const int kt0_ = lo_b + 3 * (c_); const int bo_ = ((par_) & 1) * F_BUFB; \
        _Pragma("unroll") for (int i = 0; i < 3; ++i) { if (kt0_ + i <= ktlast_b) lds_st<u32x4>(BUF, bo_ + ((C.tid >> 3) + 64 * i) * F_KROW + (C.tid & 7) * 16, st[i]); } \
        _Pragma("unroll") for (int i = 0; i < 3; ++i) { const int p_ = C.tid + 512 * i, d_ = p_ / 24, sg_ = p_ % 24; if (kt0_ + (sg_ >> 3) <= ktlast_b) lds_st<u32x4>(BUF, bo_ + F_KB + d_ * F_VROW + sg_ * 16, st[3 + i]); } } while (0)
    (void)vd; (void)vs;
    const float qkb = 8.f * LOG2E * gm * km;
    if (C.tid == 0) lds_st<unsigned>(C.lds, F_FLAG, 0u);
    FOX_LOAD(nch - 1); FOX_STORE(nch - 1, 0);
    __syncthreads();
    bool active = true;
    for (int ci = 0; ci < nch; ++ci) {
        const int c = nch - 1 - ci;
        if (c > 0) FOX_LOAD(c - 1);
        const int bo = (ci & 1) * F_BUFB;
        for (int tl = 2; tl >= 0; --tl) {
            const int kt = lo_b + 3 * c + tl;
            if (!active || kt > ktlast) continue;
            if (kt < lo || __all(qkb + (Flq - lds_ld<float>(C.lds, F_FS + (64 * kt + 63) * 4)) < mrun - 48.f)) {
                active = false; if (C.lane == 0) __hip_atomic_fetch_add((LAS unsigned*)(C.lds + F_FLAG), 1u, __ATOMIC_RELAXED, __HIP_MEMORY_SCOPE_WORKGROUP); continue; }
            const int kbase = bo + (64 * tl + r32) * F_KROW + 16 * hi;
            f32x16 s0 = (f32x16){}, s1 = (f32x16){};
#pragma unroll
            for (int d0 = 0; d0 < 4; ++d0) { const bf16x8 k0 = lds_ld<bf16x8>(BUF, kbase + 32 * d0), k1 = lds_ld<bf16x8>(BUF, kbase + 32 * F_KROW + 32 * d0); s0 = MFMA32(k0, qr[d0], s0); s1 = MFMA32(k1, qr[d0], s1); }
#pragma unroll
            for (int g = 0; g < 4; ++g) { const f32x4 fa = lds_ld<f32x4>(C.lds, F_FS + (64 * kt + 8 * g + 4 * hi) * 4), fb = lds_ld<f32x4>(C.lds, F_FS + (64 * kt + 32 + 8 * g + 4 * hi) * 4);
                s0[4 * g] += Flq - fa.x; s0[4 * g + 1] += Flq - fa.y; s0[4 * g + 2] += Flq - fa.z; s0[4 * g + 3] += Flq - fa.w;
                s1[4 * g] += Flq - fb.x; s1[4 * g + 1] += Flq - fb.y; s1[4 * g + 2] += Flq - fb.z; s1[4 * g + 3] += Flq - fb.w; }
            if (64 * kt + 63 > q0w) {
#pragma unroll
                for (int r = 0; r < 16; ++r) { const int key = 64 * kt + crow(r, hi); if (key > qrow) s0[r] = -INFINITY; if (key + 32 > qrow) s1[r] = -INFINITY; }
            }
            float mx = fmaxf(s0[0], s1[0]);
#pragma unroll
            for (int r = 1; r < 16; ++r) mx = fmaxf(mx, fmaxf(s0[r], s1[r]));
            mx = fmaxf(mx, __shfl_xor(mx, 32));
            const float mnew = fmaxf(mrun, mx), alpha = __builtin_amdgcn_exp2f(mrun - mnew); mrun = mnew;
            float rs = 0.f;
#pragma unroll
            for (int r = 0; r < 16; ++r) { s0[r] = __builtin_amdgcn_exp2f(s0[r] - mnew); s1[r] = __builtin_amdgcn_exp2f(s1[r] - mnew); rs += s0[r] + s1[r]; }
            lrun = lrun * alpha + rs;
#pragma unroll
            for (int r = 0; r < 16; ++r) { o[0][r] *= alpha; o[1][r] *= alpha; }
            const int vbase = bo + F_KB + r32 * F_VROW + (64 * tl + 4 * hi) * 2;
#pragma unroll
            for (int s2 = 0; s2 < 2; ++s2) {
                const bf16x8 p0 = pack8(s0[8 * s2], s0[8 * s2 + 1], s0[8 * s2 + 2], s0[8 * s2 + 3], s0[8 * s2 + 4], s0[8 * s2 + 5], s0[8 * s2 + 6], s0[8 * s2 + 7]);
                const bf16x8 p1 = pack8(s1[8 * s2], s1[8 * s2 + 1], s1[8 * s2 + 2], s1[8 * s2 + 3], s1[8 * s2 + 4], s1[8 * s2 + 5], s1[8 * s2 + 6], s1[8 * s2 + 7]);
#pragma unroll
                for (int dt = 0; dt < 2; ++dt) { const int vo = vbase + dt * 32 * F_VROW + 32 * s2;
                    const bf16x8 a0 = cat2(lds_ld<u32x2>(BUF, vo), lds_ld<u32x2>(BUF, vo + 16)), a1 = cat2(lds_ld<u32x2>(BUF, vo + 64), lds_ld<u32x2>(BUF, vo + 80));
                    o[dt] = MFMA32(a0, p0, o[dt]); o[dt] = MFMA32(a1, p1, o[dt]); }
            }
        }
        if (c > 0) FOX_STORE(c - 1, ci + 1);
        __syncthreads();
        if (lds_ld<unsigned>(C.lds, F_FLAG) >= 8u) break;
    }
    __syncthreads();
#undef FOX_LOAD
#undef FOX_STORE
    const float ltot = lrun + __shfl_xor(lrun, 32), inv = 1.0f / ltot;
#pragma unroll
    for (int r = 0; r < 16; ++r) { o[0][r] *= inv; o[1][r] *= inv; }
    ldsp stg = C.lds + F_STG + w * STG_BYTES;
    stage_write(stg, o, r32, hi);
    asm volatile("s_waitcnt lgkmcnt(0)" ::: "memory");
#pragma unroll
    for (int it = 0; it < 4; ++it) { const int row = 8 * it + (C.lane >> 3), ch = 8 * (C.lane & 7); const size_t m = mb + q0w + row;
        float y[8], gn[8]; unpack8(lds_ld<u32x4>(stg, row * STG_ROW + ch * 2), y); load8f(on + h * 64 + ch, gn);
        float ss = 0.f;
#pragma unroll
        for (int e = 0; e < 8; ++e) ss += y[e] * y[e];
        ss += __shfl_xor(ss, 1); ss += __shfl_xor(ss, 2); ss += __shfl_xor(ss, 4);
        const float rstd = rsqrtf(ss * (1.f / 64.f) + EPS);
#pragma unroll
        for (int e = 0; e < 8; ++e) y[e] = y[e] * rstd * gn[e];
        *(u32x4*)(Y + m * D + 256 + h * 64 + ch) = pack8u(y); }
}

__device__ __forceinline__ void scan_phase(const Ctx& C, const float* GST, const float* GD, bf16* GSB, const float* SST, const float* SD, bf16* SSB, const float* Fraw, float* Fl) {
    if (C.tid < 256) {
    for (int e = C.blk * 256 + C.tid; e < 65536; e += C.nblk * 256) { const int b = e >> 14, h = (e >> 12) & 3, vd = e & 4095, d = vd & 63;
        const float* p = GST + ((size_t)(b * 128) * 4 + h) * 4096 + vd; bf16* pb = GSB + ((size_t)(b * 128) * 4 + h) * 4096 + vd; const float* dp = GD + ((size_t)(b * 128) * 4 + h) * 64 + d; float S = 0.f;
        for (int n0 = 0; n0 < 128; n0 += 32) { float kv[32], dc[32];
#pragma unroll
            for (int j = 0; j < 32; ++j) { kv[j] = p[(size_t)(n0 + j) * 16384]; dc[j] = dp[(n0 + j) * 256]; }
#pragma unroll
            for (int j = 0; j < 32; ++j) { pb[(size_t)(n0 + j) * 16384] = f2bf(S); S = S * dc[j] + kv[j]; } } }
    } else {
    for (int e = C.blk * 256 + (C.tid - 256); e < 131072; e += C.nblk * 256) { const int b = e >> 15, h = (e >> 13) & 3, pn = e & 8191;
        const float* p = SST + ((size_t)(b * 64) * 4 + h) * 8192 + pn; bf16* pb = SSB + ((size_t)(b * 64) * 4 + h) * 8192 + pn; const float* dp = SD + (size_t)(b * 64) * 4 + h; float S = 0.f;
        for (int n0 = 0; n0 < 64; n0 += 32) { float kv[32], dc[32];
#pragma unroll
            for (int j = 0; j < 32; ++j) { kv[j] = p[(size_t)(n0 + j) * 32768]; dc[j] = dp[(n0 + j) * 4]; }
#pragma unroll
            for (int j = 0; j < 32; ++j) { pb[(size_t)(n0 + j) * 32768] = f2bf(S); S = S * dc[j] + kv[j]; } } }
    }
    for (int bh = C.blk; bh < 16; bh += C.nblk) {
        __syncthreads();
        const float* src = Fraw + (size_t)bh * L + 16 * C.tid; float v[16]; float run = 0.f;
#pragma unroll
        for (int j4 = 0; j4 < 4; ++j4) { const f32x4 a = *(const f32x4*)(src + 4 * j4); run += a.x; v[4 * j4] = run; run += a.y; v[4 * j4 + 1] = run; run += a.z; v[4 * j4 + 2] = run; run += a.w; v[4 * j4 + 3] = run; }
        float incl = run;
#pragma unroll
        for (int o_ = 1; o_ < 64; o_ <<= 1) { const float t_ = __shfl_up(incl, o_); if (C.lane >= o_) incl += t_; }
        if (C.lane == 63) lds_st<float>(C.lds, C.wave * 4, incl);
        __syncthreads();
        float pre = incl - run;
        for (int w_ = 0; w_ < C.wave; ++w_) pre += lds_ld<float>(C.lds, w_ * 4);
        float* dst = Fl + (size_t)bh * L + 16 * C.tid;
#pragma unroll
        for (int j4 = 0; j4 < 4; ++j4) *(f32x4*)(dst + 4 * j4) = (f32x4){(pre + v[4 * j4]) * LOG2E, (pre + v[4 * j4 + 1]) * LOG2E, (pre + v[4 * j4 + 2]) * LOG2E, (pre + v[4 * j4 + 3]) * LOG2E};
    }
}

#ifndef MK_PER_PHASE
#define MK_PER_PHASE 0
#endif
#ifndef PH_MASK
#define PH_MASK 0xffff
#endif
#define EN(k) ((PH_MASK >> (k)) & 1)
#ifndef DUP
#define DUP 0
#endif
#define DUPN(k) (((DUP >> (k)) & 1) ? 2 : 1)
#ifndef DUPT
#define DUPT -1
#endif
#define REPT(k) for (int rt_ = 0; rt_ < ((DUPT == (k)) ? 2 : 1); ++rt_)
constexpr int NPHASE = 1 + 9 * NLAYER;

__global__ void __launch_bounds__(NTHREADS) mega(Args a) {
    extern __shared__ __attribute__((aligned(16))) unsigned char lds_raw[];
    cg::grid_group grid = cg::this_grid();
    LAS unsigned char* glds = (LAS unsigned char*)lds_raw;
    float* X = a.out;
    volatile LAS unsigned* bst = (volatile LAS unsigned*)((ldsp)lds_raw + LDS_BYTES - 64);
    if (threadIdx.x < 16) bst[threadIdx.x] = 0u;
    __syncthreads();
    XcdBarrier bar = xcd_barrier_post((unsigned*)a.ws, bst); unsigned nbar = 0u;

    if (a.ph_hi < 0) grid.sync();
    for (int ph = a.ph_lo; ph < a.ph_hi; ++ph) {
        Ctx C; { int tid_ = threadIdx.x, blk_ = blockIdx.x, nblk_ = gridDim.x; unsigned char* ws_ = a.ws;
            asm volatile("" : "+v"(tid_)); asm volatile("" : "+s"(blk_), "+s"(nblk_), "+s"(ws_));
            C.ws = ws_; C.lds = (ldsp)lds_raw; C.tid = tid_; C.lane = tid_ & 63; C.wave = __builtin_amdgcn_readfirstlane(tid_ >> 6); C.nblk = nblk_; C.blk = blk_; }
        unsigned char* ws = C.ws;
        bf16* XN = (bf16*)(ws + WS_XN); bf16* HP = (bf16*)(ws + WS_HP); bf16* VT = (bf16*)(ws + WS_VT); bf16* YB = (bf16*)X; bf16* GSB = (bf16*)((unsigned char*)X + 64 * MiB); bf16* SSB = (bf16*)((unsigned char*)X + 80 * MiB);
        float* GST = (float*)(ws + WS_GST); float* GD = (float*)(ws + WS_GD); float* SST = (float*)(ws + WS_SST); float* SD = (float*)(ws + WS_SD);
        float* FRAW = (float*)(ws + WS_FRAW); float* FL = (float*)(ws + WS_FL); bf16* XS = (bf16*)(ws + WS_XS); unsigned long long* RS = (unsigned long long*)(ws + WS_RS);
        if (ph == 0) {
            for (int rep = 0; rep < DUPN(6); ++rep) { if (EN(0)) prologue(C, a); }
            for (int i = C.blk * NTHREADS + C.tid; i < (NLAYER * 3 - 1) * M / 2; i += C.nblk * NTHREADS) ((u32x4*)(RS + M))[i] = (u32x4){0u, 0u, 0u, 0u};
            norm_phase(C, in_ptr(a, 0), XN, RS);
        } else {
            const int q = ph - 1, l = q / 9, s = q % 9;
            unsigned char* wb = ws + WS_W + (size_t)l * W_LSTRIDE;
            if (s == 0 || s == 7) {
                pg8::Gemm g{XN, (const bf16*)(wb + (s == 0 ? WO_1U : WO_2U)), M, NUP, D}; pg8::StaticOrder S; S.init(M, NUP, C.nblk, C.blk);
                pg8::EpiSwiglu E{HP, FF, RS + (size_t)(l * 3 + (s == 0 ? 0 : 2)) * M};
                for (int rep = 0; rep < DUPN(1); ++rep) { if (EN(2)) pg8::gemm_phase<pg8::EpiSwiglu, pg8::StaticOrder, true, true>(glds, g, S, E); }
            } else if (s == 1 || s == 8 || s == 6) {
                const bf16* A = (s == 6) ? YB : HP; const int K = (s == 6) ? D : FF;
                const bf16* Bt = (const bf16*)(wb + (s == 1 ? WO_1D : s == 6 ? WO_OUT : WO_2D));
                unsigned long long* rsn = (s == 1) ? RS + (size_t)(l * 3 + 1) * M : (s == 6) ? RS + (size_t)(l * 3 + 2) * M : (l + 1 < NLAYER) ? RS + (size_t)((l + 1) * 3) * M : nullptr;
                float* outf = (s == 8 && l + 1 == NLAYER) ? X : nullptr;
                pg8::Gemm g{A, Bt, M, D, K}; pg8::StaticOrder S; S.init(M, D, C.nblk, C.blk);
                pg8::EpiResid E{XN, outf, D, (s == 6) ? 1.0f : 0.5f, rsn};
                if (EN(3)) pg8::gemm_phase<pg8::EpiResid, pg8::StaticOrder, true, true>(glds, g, S, E);
            } else if (s == 2) {
                pg8::Gemm g{XN, (const bf16*)(wb + WO_IN), M, NPG, D}; pg8::StaticOrder S; S.init(M, NPG, C.nblk, C.blk);
                pg8::EpiRowScale E{HP, NP, RS + (size_t)(l * 3 + 1) * M};
                for (int rep = 0; rep < DUPN(2); ++rep) { if (EN(4)) pg8::gemm_phase<pg8::EpiRowScale, pg8::StaticOrder, true, true>(glds, g, S, E); }
                for (int u = C.blk * 8 + C.wave; u < M / 16; u += C.nblk * 8) small_gates_unit(C, XN, (const bf16*)(wb + WO_IN), RS + (size_t)(l * 3 + 1) * M, HP, u);
            } else if (s == 3) {
                const int vblk = (C.nblk % 8 == 0) ? (C.blk % 8) * (C.nblk / 8) + C.blk / 8 : C.blk;
                for (int u = vblk; u < 1024; u += C.nblk) {
                    if (u < 512) { if (EN(5)) REPT(5) gla_passA(C, HP, GST, GD, in_ptr(a, 7) + l * 16 * 256, in_ptr(a, 8) + l * 256, u); }
                    else if (EN(6)) REPT(6) ssd_passA(C, HP, XS, SST, SD, in_ptr(a, 14) + l * 4 * 768, in_ptr(a, 15) + l * 768, in_ptr(a, 16) + l * 4, in_ptr(a, 17) + l * 4, u - 512);
                }
                const int gw = C.blk * 8 + C.wave, NGW = C.nblk * 8;
                for (int u = gw; u < 2048; u += NGW) {
                    if (u < 1024) { if (EN(7)) REPT(7) sc_unit(C, HP, YB, in_ptr(a, 20) + l * 3 * 256, in_ptr(a, 21) + l * 256, u); }
                    else if (EN(8)) foxprep_unit(C, HP, VT, FRAW, in_ptr(a, 11) + l * 64, in_ptr(a, 12) + l * 64, in_ptr(a, 10) + l * 4, u - 1024);
                }
            } else if (s == 4) {
                if (EN(9)) scan_phase(C, GST, GD, GSB, SST, SD, SSB, FRAW, FL);
            } else {
                const int vblk = (C.nblk % 8 == 0) ? (C.blk % 8) * (C.nblk / 8) + C.blk / 8 : C.blk;
                const int nun = (1536 + C.nblk - 1 - vblk) / C.nblk, rot = (C.blk & 1) ? ((nun >= 3) ? nun / 3 : 0) : 0;
                for (int k_ = 0; k_ < nun; ++k_) { const int u = vblk + ((k_ + rot) % nun) * C.nblk;
                    if (u < 512) { if (EN(10)) REPT(10) fox_attn_unit(C, HP, VT, FL, YB, in_ptr(a, 11) + l * 64, in_ptr(a, 12) + l * 64, in_ptr(a, 13) + l * 256, u); }
                    else if (u < 1024) { if (EN(11)) REPT(11) ssd_passC(C, HP, XS, SSB, YB, in_ptr(a, 14) + l * 4 * 768, in_ptr(a, 15) + l * 768, in_ptr(a, 16) + l * 4, in_ptr(a, 17) + l * 4, in_ptr(a, 18) + l * 4, in_ptr(a, 19) + l * 256, u - 512); }
                    else if (EN(12)) REPT(12) gla_passC(C, HP, GSB, YB, in_ptr(a, 7) + l * 16 * 256, in_ptr(a, 8) + l * 256, in_ptr(a, 9) + l * 256, u - 1024);
                }
            }
        }
        if (ph + 1 < a.ph_hi) { xcd_barrier_flatrel(bar, nbar); if (DUPN(5) == 2) xcd_barrier_flatrel(bar, nbar); }
    }
}

extern "C" void kernel_launch(void* const* d_in, const int* in_sizes, int n_in, void* d_out, int out_size, void* d_ws, size_t ws_size, hipStream_t stream) {
    static int grid = 0;
    if (grid == 0) {
        if (n_in != 27 || out_size != M * D || ws_size < WS_END) { fprintf(stderr, "kernel_launch: unexpected shapes (n_in %d out %d ws %zu)\n", n_in, out_size, ws_size); grid = -1; return; }
        int dev = 0, cus = 0, per_cu = 0;
        (void)hipGetDevice(&dev); (void)hipDeviceGetAttribute(&cus, hipDeviceAttributeMultiprocessorCount, dev);
        (void)hipFuncSetAttribute((const void*)mega, hipFuncAttributeMaxDynamicSharedMemorySize, LDS_BYTES);
        (void)hipOccupancyMaxActiveBlocksPerMultiprocessor(&per_cu, (const void*)mega, NTHREADS, LDS_BYTES);
        if (per_cu < 1) per_cu = 1;
        (void)hipGetLastError();
        grid = cus * per_cu;
    }
    if (grid < 0) return;
    Args a{};
    for (int i = 0; i < 27; ++i) a.in[i] = (const float*)d_in[i];
    a.out = (float*)d_out; a.ws = (unsigned char*)d_ws;
#if MK_PER_PHASE
    for (int ph = 0; ph < NPHASE; ++ph) { a.ph_lo = ph; a.ph_hi = ph + 1; hipLaunchKernelGGL(mega, dim3(grid), dim3(NTHREADS), LDS_BYTES, stream, a); }
#else
    a.ph_lo = 0; a.ph_hi = NPHASE;
    (void)hipMemsetAsync(d_ws, 0, 16384, stream);
    void* args[] = {&a};
    hipError_t e = hipLaunchCooperativeKernel((const void*)mega, dim3(grid), dim3(NTHREADS), args, LDS_BYTES, stream);
    if (e != hipSuccess) fprintf(stderr, "cooperative launch failed: %s (grid %d)\n", hipGetErrorString(e), grid);
#endif
}
```

```cpp
#include <hip/hip_runtime.h>
#include <hip/hip_cooperative_groups.h>
#include <cstdio>
#include <cstdint>
namespace cg = cooperative_groups;
namespace pg8 {
#define PG8_LAS __attribute__((address_space(3)))
typedef unsigned short bf16_t;
typedef short bf16x8 __attribute__((ext_vector_type(8)));
typedef float f32x4 __attribute__((ext_vector_type(4)));
typedef unsigned u32x4 __attribute__((ext_vector_type(4)));
constexpr int BM = 256, BK = 64, HALF = 128, HTB = HALF * BK * 2  , STAGE_BYTES = 8 * HTB, NXCD = 8, WGM = 8;

__host__ __device__ __forceinline__ int lds_byte(int r, int c) { const int st = (r >> 4) * 2 + (c >> 5), rr = r & 15, cc = c & 31, ob = rr * 64 + cc * 2; return st * 1024 + (ob ^ (((ob >> 9) & 1) << 5)); }
__host__ __device__ __forceinline__ void stage_rc(int b, int& R, int& C) { const int st = b / 1024, sb = b % 1024, swz = sb ^ (((sb >> 9) & 1) << 5); R = (st >> 1) * 16 + swz / 64; C = (st & 1) * 32 + (swz % 64) / 2; }
__host__ __device__ __forceinline__ int perm32(int rho) { const int n = rho >> 4, i = rho & 15; return 8 * (i >> 2) + 4 * n + (i & 3); }

struct Unit { int pm, pn; };
struct Gemm { const bf16_t* A; const bf16_t* Bt; int M, N, K; };

struct StaticOrder {
    int nM, nN, nwg, G, c;
    __host__ __device__ void init(int M, int N, int G_, int c_) { nM = M / BM; nN = N / BM; nwg = nM * nN; G = G_; c = c_; }
    __host__ __device__ bool next(int i, Unit& u) const {
        const long L = (long)i * G + c; if (L >= nwg) return false;
        int wgid = (int)L; { const int q = nwg / NXCD, r = nwg % NXCD, xcd = wgid % NXCD, off = wgid / NXCD; wgid = (xcd < r ? xcd * (q + 1) : r * (q + 1) + (xcd - r) * q) + off; }
        const int nig = WGM * nN, gid = wgid / nig, fm = gid * WGM, gsz = (nM - fm) < WGM ? (nM - fm) : WGM;
        u.pm = fm + ((wgid % nig) % gsz); u.pn = (wgid % nig) / gsz; return true;
    }
    __device__ __forceinline__ void a_ready(const Unit&) const {}
    __device__ __forceinline__ void done(const Unit&) const {}
};

__device__ __forceinline__ unsigned cvt_pk_bf16(float lo, float hi) { unsigned r; asm volatile("v_cvt_pk_bf16_f32 %0, %1, %2" : "=v"(r) : "v"(lo), "v"(hi)); return r; }
typedef float f32x2 __attribute__((ext_vector_type(2)));
__device__ __forceinline__ f32x2 gelu_pk(f32x2 v) {
    const f32x2 av = __builtin_elementwise_abs(v), d = av * 0.2316418882f + 1.0f;
    f32x2 t; t.x = __builtin_amdgcn_rcpf(d.x); t.y = __builtin_amdgcn_rcpf(d.y);
    f32x2 q = t * 0.5307027145f + (-0.7265760135f); q = q * t + 0.7107068705f; q = q * t + (-0.142248368f); q = q * t + 0.127414796f; q = q * t;
    const f32x2 s = (v * v) * (-0.72134752044f);
    f32x2 e; e.x = __builtin_amdgcn_exp2f(s.x); e.y = __builtin_amdgcn_exp2f(s.y);
    const f32x2 m = v * (q * e), r = v - m;
    f32x2 o; o.x = v.x < 0.f ? m.x : r.x; o.y = v.y < 0.f ? m.y : r.y; return o;
}

template <int ACT  > struct EpiBf16 {
    static constexpr bool PERM = true, AFTER_DRAIN = false; static_assert(ACT == 0 || ACT == 1, "EpiBf16: ACT is 0 (none) or 1 (gelu_pk)");
    bf16_t* O; int ldc; const float* bias; int split_cols; size_t split_stride; float scale0;
    __device__ __forceinline__ void pre(const Unit&, int, int, float (&)[8]) const {}
    __device__ __forceinline__ void operator()(const f32x4 (&acc)[2][2][4][2], const Unit& u, int wr, int wc, int fr, int fq, const float (&)[8]) const {
        const int row0 = u.pm * BM + wr * 64 + fr; int colt = u.pn * BM; bf16_t* base = O;
        float sc = 1.f; if (split_cols) { const int t = colt / split_cols; base += (size_t)t * split_stride; colt -= t * split_cols; if (t == 0) sc = scale0; }
        const int col0 = colt + wc * 32 + 8 * fq, bcol0 = u.pn * BM + wc * 32 + 8 * fq;
        f32x4 bv[2][2];
#pragma unroll
        for (int bj = 0; bj < 2; ++bj)
#pragma unroll
            for (int n = 0; n < 2; ++n) bv[bj][n] = bias ? *(const f32x4*)(bias + bcol0 + bj * HALF + 4 * n) : (f32x4){0.f, 0.f, 0.f, 0.f};
#pragma unroll
        for (int ai = 0; ai < 2; ++ai)
#pragma unroll
            for (int m = 0; m < 4; ++m) { bf16_t* rowp = base + (size_t)(row0 + ai * HALF + m * 16) * ldc + col0;
#pragma unroll
                for (int bj = 0; bj < 2; ++bj) { f32x4 v0 = acc[ai][bj][m][0] + bv[bj][0], v1 = acc[ai][bj][m][1] + bv[bj][1];
                    if (ACT == 1) { f32x2 a = gelu_pk((f32x2){v0[0], v0[1]}), b = gelu_pk((f32x2){v0[2], v0[3]}), c = gelu_pk((f32x2){v1[0], v1[1]}), d = gelu_pk((f32x2){v1[2], v1[3]});
                        v0 = (f32x4){a.x, a.y, b.x, b.y}; v1 = (f32x4){c.x, c.y, d.x, d.y}; }
                    v0 = v0 * sc; v1 = v1 * sc; u32x4 w; w.x = cvt_pk_bf16(v0[0], v0[1]); w.y = cvt_pk_bf16(v0[2], v0[3]); w.z = cvt_pk_bf16(v1[0], v1[1]); w.w = cvt_pk_bf16(v1[2], v1[3]);
                    *(u32x4*)(rowp + bj * HALF) = w; } }
    }
};
__device__ __forceinline__ float silu_f(float x) { return x * __builtin_amdgcn_rcpf(1.0f + __builtin_amdgcn_exp2f(-1.4426950408889634f * x)); }
struct EpiSwiglu {
    static constexpr bool PERM = true, AFTER_DRAIN = false;
    bf16_t* O; int ldc; const unsigned long long* rs;
    __device__ __forceinline__ void pre(const Unit& u, int wr, int fr, float (&epf)[8]) const {
#pragma unroll
        for (int k = 0; k < 8; ++k) epf[k] = (float)rs[u.pm * BM + wr * 64 + fr + (k >> 2) * HALF + (k & 3) * 16] * (1.0f / 1048576.0f);
    }
    __device__ __forceinline__ void operator()(const f32x4 (&acc)[2][2][4][2], const Unit& u, int wr, int wc, int fr, int fq, const float (&epf)[8]) const {
        const int row0 = u.pm * BM + wr * 64 + fr; const int col0 = u.pn * HALF + wc * 32 + 8 * fq;
#pragma unroll
        for (int ai = 0; ai < 2; ++ai)
#pragma unroll
            for (int m = 0; m < 4; ++m) { const int row = row0 + ai * HALF + m * 16; bf16_t* rowp = O + (size_t)row * ldc + col0;
                const float r = rsqrtf(epf[ai * 4 + m] * (1.0f / 1024.0f) + 1e-6f);
                const f32x4 g0 = acc[ai][0][m][0] * r, g1 = acc[ai][0][m][1] * r, u0 = acc[ai][1][m][0] * r, u1 = acc[ai][1][m][1] * r;
                u32x4 w; w.x = cvt_pk_bf16(silu_f(g0[0]) * u0[0], silu_f(g0[1]) * u0[1]); w.y = cvt_pk_bf16(silu_f(g0[2]) * u0[2], silu_f(g0[3]) * u0[3]);
                w.z = cvt_pk_bf16(silu_f(g1[0]) * u1[0], silu_f(g1[1]) * u1[1]); w.w = cvt_pk_bf16(silu_f(g1[2]) * u1[2], silu_f(g1[3]) * u1[3]);
                *(u32x4*)rowp = w; }
    }
};
struct EpiRowScale {
    static constexpr bool PERM = true, AFTER_DRAIN = false;
    bf16_t* O; int ldc; const unsigned long long* rs;
    __device__ __forceinline__ void pre(const Unit& u, int wr, int fr, float (&epf)[8]) const {
#pragma unroll
        for (int k = 0; k < 8; ++k) epf[k] = (float)rs[u.pm * BM + wr * 64 + fr + (k >> 2) * HALF + (k & 3) * 16] * (1.0f / 1048576.0f);
    }
    __device__ __forceinline__ void operator()(const f32x4 (&acc)[2][2][4][2], const Unit& u, int wr, int wc, int fr, int fq, const float (&epf)[8]) const {
        const int row0 = u.pm * BM + wr * 64 + fr; const int col0 = u.pn * BM + wc * 32 + 8 * fq;
#pragma unroll
        for (int ai = 0; ai < 2; ++ai)
#pragma unroll
            for (int m = 0; m < 4; ++m) { const int row = row0 + ai * HALF + m * 16; bf16_t* rowp = O + (size_t)row * ldc + col0;
                const float r = rsqrtf(epf[ai * 4 + m] * (1.0f / 1024.0f) + 1e-6f);
#pragma unroll
                for (int bj = 0; bj < 2; ++bj) { const f32x4 v0 = acc[ai][bj][m][0] * r, v1 = acc[ai][bj][m][1] * r;
                    u32x4 w; w.x = cvt_pk_bf16(v0[0], v0[1]); w.y = cvt_pk_bf16(v0[2], v0[3]); w.z = cvt_pk_bf16(v1[0], v1[1]); w.w = cvt_pk_bf16(v1[2], v1[3]);
                    *(u32x4*)(rowp + bj * HALF) = w; } }
    }
};
struct EpiResid {
    static constexpr bool PERM = false, AFTER_DRAIN = false;
    bf16_t* xb; float* outf; int ldc; float scale; unsigned long long* rsn;
    __device__ __forceinline__ void pre(const Unit&, int, int, float (&)[8]) const {}
    __device__ __forceinline__ void operator()(const f32x4 (&acc)[2][2][4][2], const Unit& u, int wr, int wc, int fr, int fq, const float (&)[8]) const {
        const int row0 = u.pm * BM + wr * 64 + fr; const int col0 = u.pn * BM + wc * 32 + 4 * fq;
        typedef unsigned u32x2v __attribute__((ext_vector_type(2)));
#pragma unroll
        for (int ai = 0; ai < 2; ++ai)
#pragma unroll
            for (int m = 0; m < 4; ++m) { const int row = row0 + ai * HALF + m * 16; const size_t off = (size_t)row * ldc + col0; float ss = 0.f;
                u32x2v bs[2][2];
#pragma unroll
                for (int bj = 0; bj < 2; ++bj)
#pragma unroll
                    for (int n = 0; n < 2; ++n) bs[bj][n] = *(const u32x2v*)(xb + off + bj * HALF + n * 16);
#pragma unroll
                for (int bj = 0; bj < 2; ++bj)
#pragma unroll
                    for (int n = 0; n < 2; ++n) { const f32x4 b4 = (f32x4){__uint_as_float(bs[bj][n].x << 16), __uint_as_float(bs[bj][n].x & 0xffff0000u), __uint_as_float(bs[bj][n].y << 16), __uint_as_float(bs[bj][n].y & 0xffff0000u)};
                        const f32x4 v = b4 + acc[ai][bj][m][n] * scale;
                        if (outf) { *(f32x4*)(outf + off + bj * HALF + n * 16) = v; }
                        else { u32x2v w; w.x = cvt_pk_bf16(v[0], v[1]); w.y = cvt_pk_bf16(v[2], v[3]); *(u32x2v*)(xb + off + bj * HALF + n * 16) = w;
                            const float r0 = __uint_as_float(w.x << 16), r1 = __uint_as_float(w.x & 0xffff0000u), r2 = __uint_as_float(w.y << 16), r3 = __uint_as_float(w.y & 0xffff0000u);
                            ss += (r0 * r0 + r1 * r1) + (r2 * r2 + r3 * r3); } }
                if (rsn) { ss += __shfl_xor(ss, 16); ss += __shfl_xor(ss, 32); if (fq == 0) atomicAdd(rsn + row, (unsigned long long)(ss * 1048576.0f + 0.5f)); } }
    }
};
template <class Epi, class Sched, bool ALIGN_EPI = false, bool SP2 = false>
__device__ __forceinline__ void gemm_phase(PG8_LAS unsigned char* lds, const Gemm g, const Sched& S, const Epi& E) {
    int tid_l = threadIdx.x; asm volatile("" : "+v"(tid_l));
    const int tid = tid_l, wid = __builtin_amdgcn_readfirstlane(tid >> 6), lane = tid & 63, wr = wid >> 2, wc = wid & 3, fr = lane & 15, fq = lane >> 4;
    const int K = g.K, nt = K / BK;
    unsigned voffA[2], voffB[2];
#pragma unroll
    for (int i = 0; i < 2; ++i) { int R, C; stage_rc(tid * 16 + i * 8192, R, C); const int Rb = Epi::PERM ? ((R & ~31) + perm32(R & 31)) : R;
        voffA[i] = (unsigned)(R * K + C) * 2u; voffB[i] = (unsigned)(Rb * K + C) * 2u; }
    const size_t kstep = (size_t)(BK * 2);
    const size_t hstep = (size_t)HALF * K * 2;
    const size_t tstep = 2 * hstep;
    const unsigned ldsw = (unsigned)wid * 1024u;
    const int aoff = lds_byte(wr * 64 + fr, fq * 8), boff = lds_byte(wc * 32 + fr, fq * 8);
#define PG8_SA(b, h) (((b) * 2 + (h)) * HTB)
#define PG8_SB(b, h) ((4 + (b) * 2 + (h)) * HTB)
#define PG8_STAGE(bufoff, gbase, voff) do { _Pragma("unroll") for (int _i = 0; _i < 2; ++_i) \
        __builtin_amdgcn_global_load_lds((const unsigned*)((const char*)(gbase) + (voff)[_i]), (PG8_LAS unsigned*)(lds + (bufoff) + ldsw + _i * 8192), 16, 0, 0); } while (0)
#define PG8_LDA(dst, b, h) do { _Pragma("unroll") for (int m = 0; m < 4; ++m) _Pragma("unroll") for (int k = 0; k < 2; ++k) dst[m][k] = *(const PG8_LAS bf16x8*)(lds + PG8_SA(b, h) + aoff + m * 2048 + k * 1024); } while (0)
#define PG8_LDB(dst, b, h) do { _Pragma("unroll") for (int n = 0; n < 2; ++n) _Pragma("unroll") for (int k = 0; k < 2; ++k) dst[n][k] = *(const PG8_LAS bf16x8*)(lds + PG8_SB(b, h) + boff + n * 2048 + k * 1024); } while (0)
#define PG8_MMA(ai, bj, At, Bt) do { __builtin_amdgcn_s_setprio(1); _Pragma("unroll") for (int m = 0; m < 4; ++m) _Pragma("unroll") for (int n = 0; n < 2; ++n) _Pragma("unroll") for (int k = 0; k < 2; ++k) \
        acc[ai][bj][m][n] = __builtin_amdgcn_mfma_f32_16x16x32_bf16(Bt[n][k], At[m][k], acc[ai][bj][m][n], 0, 0, 0); __builtin_amdgcn_s_setprio(0); } while (0)
#define PG8_WAIT_V(n) asm volatile("s_waitcnt vmcnt(" #n ")" ::: "memory")
#define PG8_WAIT_L(n) asm volatile("s_waitcnt lgkmcnt(" #n ")" ::: "memory")
#define PG8_BAR __builtin_amdgcn_s_barrier()
#define PG8_SCHED __builtin_amdgcn_sched_barrier(0)
    Unit cur, nxt; int ui = 0;
    if (!S.next(0, cur)) return;
    float epf[8]; E.pre(cur, wr, fr, epf);
    f32x4 acc[2][2][4][2];
#pragma unroll
    for (int a = 0; a < 2; ++a)
#pragma unroll
        for (int b = 0; b < 2; ++b)
#pragma unroll
            for (int m = 0; m < 4; ++m)
#pragma unroll
                for (int n = 0; n < 2; ++n) acc[a][b][m][n] = (f32x4){0.f, 0.f, 0.f, 0.f};
    bf16x8 At[4][2], B0[2][2], B1[2][2];
    const char* cA = (const char*)g.A + (size_t)cur.pm * tstep; const char* cB = (const char*)g.Bt + (size_t)cur.pn * tstep;
    S.a_ready(cur);
    if constexpr (SP2) {
        PG8_STAGE(PG8_SB(0, 0), cB, voffB); PG8_STAGE(PG8_SB(0, 1), cB + hstep, voffB); PG8_STAGE(PG8_SA(0, 0), cA, voffA); PG8_STAGE(PG8_SA(0, 1), cA + hstep, voffA);
        if (wr == 1) PG8_BAR;
        PG8_WAIT_V(2); PG8_BAR;
        PG8_STAGE(PG8_SB(1, 0), cB + kstep, voffB); PG8_STAGE(PG8_SA(1, 0), cA + kstep, voffA); PG8_STAGE(PG8_SB(1, 1), cB + hstep + kstep, voffB);
        PG8_WAIT_V(6); PG8_BAR;
    } else {
        PG8_STAGE(PG8_SB(0, 0), cB, voffB); PG8_STAGE(PG8_SA(0, 0), cA, voffA); PG8_STAGE(PG8_SB(0, 1), cB + hstep, voffB); PG8_STAGE(PG8_SA(0, 1), cA + hstep, voffA);
        if (wr == 1) PG8_BAR;
        PG8_WAIT_V(4); PG8_BAR;
        PG8_STAGE(PG8_SB(1, 0), cB + kstep, voffB); PG8_STAGE(PG8_SA(1, 0), cA + kstep, voffA); PG8_STAGE(PG8_SB(1, 1), cB + hstep + kstep, voffB);
        PG8_WAIT_V(6); PG8_BAR;
    }
    for (;;) {
        const bool has_next = S.next(ui + 1, nxt);
        const char* nA = has_next ? (const char*)g.A + (size_t)nxt.pm * tstep : cA; const char* nB = has_next ? (const char*)g.Bt + (size_t)nxt.pn * tstep : cB;
        for (int t = 0; t < nt; t += 2) {
            const bool last = (t == nt - 2);
            const char* a1 = cA + (size_t)(t + 1) * kstep;
            const char* a2 = last ? nA : cA + (size_t)(t + 2) * kstep; const char* b2 = last ? nB : cB + (size_t)(t + 2) * kstep;
            const char* a3 = a2 + kstep; const char* b3 = b2 + kstep;
            if (last && has_next) S.a_ready(nxt);
            if constexpr (SP2) {
            PG8_LDB(B0, 0, 0); PG8_LDB(B1, 0, 1); PG8_SCHED; PG8_LDA(At, 0, 0); PG8_STAGE(PG8_SA(1, 1), a1 + hstep, voffA);
            PG8_WAIT_V(8); PG8_WAIT_L(0); PG8_BAR; PG8_MMA(0, 0, At, B0); PG8_MMA(0, 1, At, B1); PG8_BAR; PG8_SCHED;
            PG8_LDA(At, 0, 1); PG8_STAGE(PG8_SB(0, 0), b2, voffB); PG8_STAGE(PG8_SB(0, 1), b2 + hstep, voffB); PG8_STAGE(PG8_SA(0, 0), a2, voffA);
            PG8_WAIT_V(8); PG8_WAIT_L(0); PG8_BAR; PG8_MMA(1, 0, At, B0); PG8_MMA(1, 1, At, B1); PG8_BAR; PG8_SCHED;
            PG8_LDB(B0, 1, 0); PG8_LDB(B1, 1, 1); PG8_SCHED; PG8_LDA(At, 1, 0); PG8_STAGE(PG8_SA(0, 1), a2 + hstep, voffA);
            PG8_WAIT_V(8); PG8_WAIT_L(0); PG8_BAR; PG8_MMA(0, 0, At, B0); PG8_MMA(0, 1, At, B1); PG8_BAR; PG8_SCHED;
            PG8_LDA(At, 1, 1); PG8_STAGE(PG8_SB(1, 0), b3, voffB); PG8_STAGE(PG8_SB(1, 1), b3 + hstep, voffB); PG8_STAGE(PG8_SA(1, 0), a3, voffA);
            PG8_WAIT_V(8); PG8_WAIT_L(0); PG8_BAR; PG8_MMA(1, 0, At, B0); PG8_MMA(1, 1, At, B1); PG8_BAR; PG8_SCHED;
            } else {
            PG8_LDB(B0, 0, 0); PG8_SCHED; PG8_LDA(At, 0, 0); PG8_STAGE(PG8_SA(1, 1), a1 + hstep, voffA);
            PG8_WAIT_L(8); PG8_BAR; PG8_WAIT_L(0); PG8_MMA(0, 0, At, B0); PG8_BAR; PG8_SCHED;
            PG8_LDB(B1, 0, 1); PG8_STAGE(PG8_SB(0, 0), b2, voffB);
            PG8_BAR; PG8_WAIT_L(0); PG8_MMA(0, 1, At, B1); PG8_BAR;
            PG8_LDA(At, 0, 1); PG8_STAGE(PG8_SA(0, 0), a2, voffA);
            PG8_BAR; PG8_WAIT_L(0); PG8_MMA(1, 0, At, B0); PG8_BAR; PG8_SCHED;
            PG8_STAGE(PG8_SB(0, 1), b2 + hstep, voffB);
            PG8_WAIT_V(6); PG8_BAR; PG8_MMA(1, 1, At, B1); PG8_BAR;
            PG8_LDB(B0, 1, 0); PG8_SCHED; PG8_LDA(At, 1, 0); PG8_STAGE(PG8_SA(0, 1), a2 + hstep, voffA);
            PG8_WAIT_L(8); PG8_BAR; PG8_WAIT_L(0); PG8_MMA(0, 0, At, B0); PG8_BAR; PG8_SCHED;
            PG8_LDB(B1, 1, 1); PG8_STAGE(PG8_SB(1, 0), b3, voffB);
            PG8_BAR; PG8_WAIT_L(0); PG8_MMA(0, 1, At, B1); PG8_BAR;
            PG8_LDA(At, 1, 1); PG8_STAGE(PG8_SA(1, 0), a3, voffA);
            PG8_BAR; PG8_WAIT_L(0); PG8_MMA(1, 0, At, B0); PG8_BAR; PG8_SCHED;
            PG8_STAGE(PG8_SB(1, 1), b3 + hstep, voffB);
            PG8_WAIT_V(6); PG8_BAR; PG8_MMA(1, 1, At, B1); PG8_BAR;
            }
        }
        if constexpr (ALIGN_EPI) { if (wr == 0) PG8_BAR; }
        if constexpr (!Epi::AFTER_DRAIN) { E(acc, cur, wr, wc, fr, fq, epf); S.done(cur); }
        if (!has_next) break;
#pragma unroll
        for (int a = 0; a < 2; ++a)
#pragma unroll
            for (int b = 0; b < 2; ++b)
#pragma unroll
                for (int m = 0; m < 4; ++m)
#pragma unroll
                    for (int n = 0; n < 2; ++n) acc[a][b][m][n] = (f32x4){0.f, 0.f, 0.f, 0.f};
        cur = nxt; cA = nA; cB = nB; ++ui;
        E.pre(cur, wr, fr, epf);
        if constexpr (ALIGN_EPI) { if (wr == 1) PG8_BAR; }
    }
    PG8_WAIT_V(0);
    if constexpr (!ALIGN_EPI) { if (wr == 0) PG8_BAR; }
    PG8_BAR;
    if constexpr (Epi::AFTER_DRAIN) { E.fused(acc, cur, wr, wc, fr, fq, lds, wid, lane); S.done(cur); }
#undef PG8_SA
#undef PG8_SB
#undef PG8_STAGE
#undef PG8_LDA
#undef PG8_LDB
#undef PG8_MMA
#undef PG8_WAIT_V
#undef PG8_WAIT_L
#undef PG8_BAR
#undef PG8_SCHED
}
}

#define LAS __attribute__((address_space(3)))
typedef LAS unsigned char* ldsp;
typedef unsigned short bf16;
typedef short bf16x8 __attribute__((ext_vector_type(8)));
typedef float f32x4 __attribute__((ext_vector_type(4)));
typedef float f32x16 __attribute__((ext_vector_type(16)));
typedef unsigned u32x4 __attribute__((ext_vector_type(4)));
typedef unsigned u32x2 __attribute__((ext_vector_type(2)));
typedef float f32x2_t __attribute__((ext_vector_type(2)));
typedef __bf16 bf16x2_t __attribute__((ext_vector_type(2)));

constexpr int NBATCH = 4, L = 8192, M = NBATCH * L, D = 1024, FF = 2816, NUP = 2 * FF, NP = 3840, NPG = 3584, NLAYER = 2;
constexpr float EPS = 1e-6f, LOG2E = 1.4426950408889634f;
constexpr int PC_AQ = 0, PC_AK = 256, PC_AV = 512, PC_AG = 768, PC_BQ = 1024, PC_BK = 1280, PC_BV = 1536, PC_CZ = 1792, PC_XBC = 2048,
              PC_DB = 2816, PC_DC = 3072, PC_DV = 3328, PC_ALR = 3584, PC_BF = 3600, PC_DT = 3604;
constexpr size_t MiB = 1u << 20;
constexpr size_t WS_W = 1 * MiB, W_LSTRIDE = 42 * MiB + 512 * 1024;
constexpr size_t WO_1U = 0, WO_1D = 11 * MiB, WO_IN = 16 * MiB + 512 * 1024, WO_OUT = 24 * MiB, WO_2U = 26 * MiB, WO_2D = 37 * MiB;
constexpr size_t WS_RS = 489 * MiB;
constexpr size_t WS_XN = 86 * MiB;
constexpr size_t WS_HP = 150 * MiB;
constexpr size_t WS_XG2 = WS_HP + 176 * MiB;
constexpr size_t WS_VT = 390 * MiB;
constexpr size_t WS_GST = 406 * MiB;
constexpr size_t WS_GD = 438 * MiB;
constexpr size_t WS_SST = 439 * MiB;
constexpr size_t WS_SD = 471 * MiB;
constexpr size_t WS_FRAW = 471 * MiB + 65536;
constexpr size_t WS_FL = 472 * MiB;
constexpr size_t WS_XS = 473 * MiB;
constexpr size_t WS_END = 491 * MiB;
constexpr int LDS_BYTES = 150 * 1024;
constexpr int NTHREADS = 512;

template <class T> __device__ __forceinline__ T lds_ld(ldsp p, int off) { return *(const LAS T*)(p + off); }
template <class T> __device__ __forceinline__ void lds_st(ldsp p, int off, T v) { *(LAS T*)(p + off) = v; }
__device__ __forceinline__ ldsp lds_opaque(ldsp p) { unsigned a = (unsigned)(size_t)p; asm volatile("" : "+v"(a)); return (ldsp)(size_t)a; }
__device__ __forceinline__ float bf2f(bf16 u) { return __uint_as_float((unsigned)u << 16); }
__device__ __forceinline__ unsigned pk2(float lo, float hi) { f32x2_t v = {lo, hi}; bf16x2_t b = __builtin_convertvector(v, bf16x2_t); return __builtin_bit_cast(unsigned, b); }
__device__ __forceinline__ bf16 f2bf(float f) { return (bf16)(pk2(f, 0.f) & 0xffffu); }
__device__ __forceinline__ float lo16(unsigned w) { return __uint_as_float(w << 16); }
__device__ __forceinline__ float hi16(unsigned w) { return __uint_as_float(w & 0xffff0000u); }
__device__ __forceinline__ bf16x8 pack8(float a0, float a1, float a2, float a3, float a4, float a5, float a6, float a7) {
    u32x4 w; w.x = pk2(a0, a1); w.y = pk2(a2, a3); w.z = pk2(a4, a5); w.w = pk2(a6, a7); return __builtin_bit_cast(bf16x8, w); }
__device__ __forceinline__ bf16x8 cat2(u32x2 a, u32x2 b) { u32x4 w; w.x = a.x; w.y = a.y; w.z = b.x; w.w = b.y; return __builtin_bit_cast(bf16x8, w); }
__device__ __forceinline__ float silu(float x) { return x / (1.0f + __expf(-x)); }
__device__ __forceinline__ float logsigmoid(float x) { return fminf(x, 0.f) - log1pf(__expf(-fabsf(x))); }
__device__ __forceinline__ float softplus(float x) { return fmaxf(x, 0.f) + log1pf(__expf(-fabsf(x))); }
__device__ __forceinline__ int crow(int r, int hi) { return (r & 3) + 8 * (r >> 2) + 4 * hi; }
#define MFMA32(a, b, c) __builtin_amdgcn_mfma_f32_32x32x16_bf16((a), (b), (c), 0, 0, 0)
__device__ __forceinline__ void unpack8(u32x4 w, float (&o)[8]) { o[0] = lo16(w.x); o[1] = hi16(w.x); o[2] = lo16(w.y); o[3] = hi16(w.y); o[4] = lo16(w.z); o[5] = hi16(w.z); o[6] = lo16(w.w); o[7] = hi16(w.w); }

struct Ctx {
    unsigned char* ws;
    ldsp lds; int tid, lane, wave, nblk, blk;
};

__device__ __forceinline__ Ctx relaunder(const Ctx& C0) { Ctx C = C0; int t = C0.tid; asm volatile("" : "+v"(t)); C.tid = t; C.lane = t & 63; C.wave = __builtin_amdgcn_readfirstlane(t >> 6); return C; }

__device__ __forceinline__ int win_src_col(int j) {
    if (j < 1024) return j;
    if (j < 1792) return j + 16;
    if (j < 2816) return j + 20;
    if (j < 3584) return j + 24;
    if (j < 3600) return 1024 + (j - 3584);
    if (j < 3604) return 1808 + (j - 3600);
    if (j < 3608) return 2836 + (j - 3604);
    return -1;
}
__device__ __forceinline__ void wt_item(int kind, const float* W0, const float* W1, const float* gsc, int K, int Nsrc, int Ndst, bf16* WT, ldsp scr, int item, int lane) {
    const int nblk = Ndst / 32, kb = item / nblk, nb = item % nblk, k0 = 64 * kb, n0 = 32 * nb;
    const int nd = n0 + (lane & 31);
    const float* src = W0; int col = nd;
    if (kind == 1) { const int pn = nd >> 8, bj = (nd >> 7) & 1, cc = nd & 127; src = bj ? W1 : W0; col = pn * 128 + cc; }
    else if (kind == 2) { col = win_src_col(nd); }
    float vv[32];
#pragma unroll
    for (int i = 0; i < 32; ++i) { const int kk = 2 * i + (lane >> 5); vv[i] = (col >= 0) ? src[(size_t)(k0 + kk) * Nsrc + col] : 0.f; }
    float gs = 1.f; const float* gp = gsc ? gsc + k0 + (lane >> 5) : nullptr;
#pragma unroll
    for (int i = 0; i < 32; ++i) { const int kk = 2 * i + (lane >> 5); if (gp) gs = gp[2 * i]; lds_st<float>(scr, (kk * 33 + (lane & 31)) * 4, vv[i] * gs); }
    asm volatile("s_waitcnt lgkmcnt(0)" ::: "memory");
    const int c = lane & 7;
#pragma unroll
    for (int j = 0; j < 4; ++j) { const int n = (lane >> 3) + 8 * j; const int so = ((8 * c) * 33 + n) * 4;
        u32x4 o; o.x = pk2(lds_ld<float>(scr, so), lds_ld<float>(scr, so + 33 * 4)); o.y = pk2(lds_ld<float>(scr, so + 2 * 33 * 4), lds_ld<float>(scr, so + 3 * 33 * 4));
        o.z = pk2(lds_ld<float>(scr, so + 4 * 33 * 4), lds_ld<float>(scr, so + 5 * 33 * 4)); o.w = pk2(lds_ld<float>(scr, so + 6 * 33 * 4), lds_ld<float>(scr, so + 7 * 33 * 4));
        *(u32x4*)(WT + (size_t)(n0 + n) * K + k0 + 8 * c) = o; }
    asm volatile("s_waitcnt lgkmcnt(0)" ::: "memory");
}
struct Args { const float* in[27]; float* out; unsigned char* ws; int ph_lo, ph_hi; };
__device__ __forceinline__ const float* in_ptr(const Args& a, int k) { asm volatile("" : "+s"(k)); return a.in[k]; }
__device__ __forceinline__ void prologue(const Ctx& C, const Args& A) {
    ldsp scr = C.lds + C.wave * 8448;
    const int gw = C.blk * 8 + C.wave, NGW = C.nblk * 8;
    constexpr int I_U = 16 * (NUP / 32), I_D = (FF / 64) * 32, I_IN = 16 * (NP / 32), I_O = 16 * 32, I_L = 2 * I_U + 2 * I_D + I_IN + I_O;
    for (int it = gw; it < NLAYER * I_L; it += NGW) {
        const int l = it / I_L; int r = it % I_L;
        unsigned char* wb = C.ws + WS_W + (size_t)l * W_LSTRIDE;
        const size_t o_gu = (size_t)l * D * FF, o_dn = (size_t)l * FF * D;
        if (r < I_U) { wt_item(1, in_ptr(A, 2) + o_gu, in_ptr(A, 3) + o_gu, in_ptr(A, 1) + l * D, D, FF, NUP, (bf16*)(wb + WO_1U), scr, r, C.lane); continue; } r -= I_U;
        if (r < I_D) { wt_item(0, in_ptr(A, 4) + o_dn, nullptr, nullptr, FF, D, D, (bf16*)(wb + WO_1D), scr, r, C.lane); continue; } r -= I_D;
        if (r < I_IN) { wt_item(2, in_ptr(A, 6) + (size_t)l * D * 3608, nullptr, in_ptr(A, 5) + l * D, D, 3608, NP, (bf16*)(wb + WO_IN), scr, r, C.lane); continue; } r -= I_IN;
        if (r < I_O) { wt_item(0, in_ptr(A, 22) + (size_t)l * D * D, nullptr, nullptr, D, D, D, (bf16*)(wb + WO_OUT), scr, r, C.lane); continue; } r -= I_O;
        if (r < I_U) { wt_item(1, in_ptr(A, 24) + o_gu, in_ptr(A, 25) + o_gu, in_ptr(A, 23) + l * D, D, FF, NUP, (bf16*)(wb + WO_2U), scr, r, C.lane); continue; } r -= I_U;
        wt_item(0, in_ptr(A, 26) + o_dn, nullptr, nullptr, FF, D, D, (bf16*)(wb + WO_2D), scr, r, C.lane);
    }
}
__device__ __forceinline__ float wave_sum(float v) {
#pragma unroll
    for (int o = 1; o < 64; o <<= 1) v += __shfl_xor(v, o);
    return v;
}
__device__ __forceinline__ void norm_phase(const Ctx& C, const float* x, bf16* xb, unsigned long long* rs) {
    const int gw = C.blk * 8 + C.wave, NGW = C.nblk * 8;
    for (int m = 4 * gw; m < M; m += 4 * NGW) {
        f32x4 v[4][4];
#pragma unroll
        for (int q = 0; q < 4; ++q) { const f32x4* xr = (const f32x4*)(x + (size_t)(m + q) * D) + C.lane;
#pragma unroll
            for (int j = 0; j < 4; ++j) v[q][j] = xr[64 * j]; }
#pragma unroll
        for (int q = 0; q < 4; ++q) { u32x2* o8 = (u32x2*)(xb + (size_t)(m + q) * D) + C.lane; float s = 0.f;
#pragma unroll
            for (int j = 0; j < 4; ++j) { const f32x4 t = v[q][j]; u32x2 w; w.x = pk2(t.x, t.y); w.y = pk2(t.z, t.w); o8[64 * j] = w;
                const float r0 = lo16(w.x), r1 = hi16(w.x), r2 = lo16(w.y), r3 = hi16(w.y); s += (r0 * r0 + r1 * r1) + (r2 * r2 + r3 * r3); }
            s = wave_sum(s);
            if (C.lane == 0) rs[m + q] = (unsigned long long)(s * 1048576.0f + 0.5f); }
    }
}
#define XB_TMO      128
#define XB_XCNT(j)  (256  + 64 * (j))
#define XB_XSUB(j)  (1280 + 64 * (j))
#define XB_XGEN(j)  (2304 + 64 * (j))
#define XB_TOP      3328
#define XB_TOPGEN   3392
#define XCD_BAR_WORDS 3456
#define XB_SPIN_CAP (1u << 18)

__device__ __forceinline__ unsigned xb_ld(unsigned* p)              { return __hip_atomic_load(p, __ATOMIC_RELAXED, __HIP_MEMORY_SCOPE_AGENT); }
__device__ __forceinline__ unsigned xb_add(unsigned* p, unsigned v) { return __hip_atomic_fetch_add(p, v, __ATOMIC_RELAXED, __HIP_MEMORY_SCOPE_AGENT); }
__device__ __forceinline__ unsigned xb_xcc_id() { return (unsigned)__builtin_amdgcn_s_getreg((3 << 11) | 20) & 0xFu; }
#define XB_SPIN(cond, bar) do { unsigned _sp = 0; while (cond) { __builtin_amdgcn_s_sleep(1); \
    if ((++_sp & 255u) == 0u) { if (xb_ld(&(bar)[XB_TMO])) break; if (_sp > XB_SPIN_CAP) { atomicAdd(&(bar)[XB_TMO], 1u); break; } } } } while (0)

struct XcdBarrier {
    unsigned* bar; unsigned x;
    volatile LAS unsigned* st;
};

__device__ __forceinline__ XcdBarrier xcd_barrier_post(unsigned* bar, volatile LAS unsigned* st) {
    XcdBarrier b; b.bar = bar; b.x = xb_xcc_id(); b.st = st;
    if (threadIdx.x == 0) (void)xb_add(&bar[XB_XCNT(b.x)], 1u);
    return b;
}
__device__ __forceinline__ void xcd_barrier_complete(unsigned* bar, unsigned x, unsigned& nloc, unsigned& nx) {
    const unsigned G = gridDim.x * gridDim.y * gridDim.z;
    unsigned sum, cnt, mine, sp = 0u;
    for (;;) {
        sum = 0u; cnt = 0u; mine = 0u;
#pragma unroll
        for (unsigned j = 0; j < 16; ++j) { const unsigned c = xb_ld(&bar[XB_XCNT(j)]); sum += c; cnt += (c > 0u) ? 1u : 0u; mine = (j == x) ? c : mine; }
        if (sum == G) break;
        __builtin_amdgcn_s_sleep(1);
        if ((++sp & 255u) == 0u) { if (xb_ld(&bar[XB_TMO])) break; if (sp > XB_SPIN_CAP) { atomicAdd(&bar[XB_TMO], 1u); break; } }
    }
    nloc = mine > 0u ? mine : 1u; nx = cnt > 0u ? cnt : 1u;
}

__device__ __forceinline__ void xcd_barrier(const XcdBarrier& b) {
    asm volatile("s_waitcnt vmcnt(0)" ::: "memory");
    __syncthreads();
    if (threadIdx.x == 0) {
        unsigned* bar = b.bar;
        __builtin_amdgcn_s_waitcnt(0);
        unsigned nloc = b.st[0], nx = b.st[1];
        if (nloc == 0u) { xcd_barrier_complete(bar, b.x, nloc, nx); b.st[0] = nloc; b.st[1] = nx; }
        const unsigned old = xb_add(&bar[XB_XSUB(b.x)], 1u);
        const unsigned gen = old / nloc;
        if (old + 1u == (gen + 1u) * nloc) {
            __builtin_amdgcn_fence(__ATOMIC_RELEASE, "agent");
            asm volatile("s_waitcnt vmcnt(0)" ::: "memory");
            const unsigned og = xb_add(&bar[XB_TOP], 1u);
            const unsigned tg = og / nx;
            if (og + 1u == (tg + 1u) * nx) xb_add(&bar[XB_TOPGEN], 1u);
            else XB_SPIN(xb_ld(&bar[XB_TOPGEN]) == tg, bar);
            __builtin_amdgcn_fence(__ATOMIC_ACQUIRE, "agent");
            xb_add(&bar[XB_XGEN(b.x)], 1u);
            asm volatile("s_waitcnt vmcnt(0)" ::: "memory");
        } else {
            XB_SPIN(xb_ld(&bar[XB_XGEN(b.x)]) == gen, bar);
            __builtin_amdgcn_fence(__ATOMIC_ACQUIRE, "agent");
            asm volatile("s_waitcnt vmcnt(0)" ::: "memory");
        }
    }
    __syncthreads();
}

__device__ __forceinline__ void xcd_barrier_flatrel(const XcdBarrier& b, unsigned& kcount) {
    asm volatile("s_waitcnt vmcnt(0)" ::: "memory");
    __syncthreads();
    if (threadIdx.x == 0) {
        unsigned* bar = b.bar;
        __builtin_amdgcn_s_waitcnt(0);
        unsigned nloc = b.st[0], nx = b.st[1];
        if (nloc == 0u) { xcd_barrier_complete(bar, b.x, nloc, nx); b.st[0] = nloc; b.st[1] = nx; }
        const unsigned old = xb_add(&bar[XB_XSUB(b.x)], 1u);
        const unsigned gen = old / nloc;
        if (old + 1u == (gen + 1u) * nloc) {
            __builtin_amdgcn_fence(__ATOMIC_RELEASE, "agent");
            asm volatile("s_waitcnt vmcnt(0)" ::: "memory");
            const unsigned og = xb_add(&bar[XB_TOP], 1u);
            const unsigned tg = og / nx;
            if (og + 1u == (tg + 1u) * nx) xb_add(&bar[XB_TOPGEN], 1u);
        }
        const unsigned want = kcount + 1u;
        XB_SPIN(xb_ld(&bar[XB_TOPGEN]) < want, bar);
        __builtin_amdgcn_fence(__ATOMIC_ACQUIRE, "agent");
        asm volatile("s_waitcnt vmcnt(0)" ::: "memory");
    }
    __syncthreads();
    ++kcount;
}

constexpr int STG_ROW = 144, STG_BYTES = 32 * STG_ROW;
__device__ __forceinline__ void stage_write(ldsp st, const f32x16 (&o)[2], int r32, int hi) {
#pragma unroll
    for (int vt = 0; vt < 2; ++vt)
#pragma unroll
        for (int g = 0; g < 4; ++g) { u32x2 w; w.x = pk2(o[vt][4 * g], o[vt][4 * g + 1]); w.y = pk2(o[vt][4 * g + 2], o[vt][4 * g + 3]);
            lds_st<u32x2>(st, r32 * STG_ROW + (32 * vt + 8 * g + 4 * hi) * 2, w); }
}
__device__ __forceinline__ void load8f(const float* p, float (&o)[8]) { const f32x4 a = *(const f32x4*)p, b = *(const f32x4*)(p + 4); o[0] = a.x; o[1] = a.y; o[2] = a.z; o[3] = a.w; o[4] = b.x; o[5] = b.y; o[6] = b.z; o[7] = b.w; }
__device__ __forceinline__ bf16x8 ldg_f32_as_bf16x8(const float* p) { const f32x4 a = *(const f32x4*)p, b = *(const f32x4*)(p + 4); return pack8(a.x, a.y, a.z, a.w, b.x, b.y, b.z, b.w); }
__device__ __forceinline__ u32x4 pack8u(const float (&v)[8]) { u32x4 w; w.x = pk2(v[0], v[1]); w.y = pk2(v[2], v[3]); w.z = pk2(v[4], v[5]); w.w = pk2(v[6], v[7]); return w; }


__device__ __forceinline__ void small_gates_unit(const Ctx& C0, const bf16* Xb, const bf16* Wt, const unsigned long long* rs, bf16* P, int unit) {
    const Ctx C = relaunder(C0);
    typedef float f32x4v __attribute__((ext_vector_type(4)));
    const int r16 = C.lane & 15, kq = C.lane >> 4, m0 = 16 * unit;
    const bf16* ap = Wt + (size_t)(NPG + r16) * D + 8 * kq; const bf16* bp = Xb + (size_t)(m0 + r16) * D + 8 * kq;
    f32x4v acc0 = (f32x4v){0.f, 0.f, 0.f, 0.f}, acc1 = acc0;
#pragma unroll 1
    for (int half = 0; half < 2; ++half) {
        bf16x8 a0[16], a1[16], bb[16];
#pragma unroll
        for (int s = 0; s < 16; ++s) { const int ko = 32 * (16 * half + s); a0[s] = *(const bf16x8*)(ap + ko); a1[s] = *(const bf16x8*)(ap + (size_t)16 * D + ko); bb[s] = *(const bf16x8*)(bp + ko); }
#pragma unroll
        for (int s = 0; s < 16; ++s) { acc0 = __builtin_amdgcn_mfma_f32_16x16x32_bf16(a0[s], bb[s], acc0, 0, 0, 0); acc1 = __builtin_amdgcn_mfma_f32_16x16x32_bf16(a1[s], bb[s], acc1, 0, 0, 0); }
    }
    const float rstd = rsqrtf((float)rs[m0 + r16] * (1.0f / 1048576.0f) * (1.0f / 1024.0f) + EPS);
    bf16* o = P + (size_t)(m0 + r16) * NP + NPG + 4 * kq;
    { u32x2 w; w.x = pk2(acc0[0] * rstd, acc0[1] * rstd); w.y = pk2(acc0[2] * rstd, acc0[3] * rstd); *(u32x2*)o = w; }
    if (kq < 2) { u32x2 w; w.x = pk2(acc1[0] * rstd, acc1[1] * rstd); w.y = pk2(acc1[2] * rstd, acc1[3] * rstd); *(u32x2*)(o + 16) = w; }
}
__device__ __forceinline__ f32x4 sc_cv(const bf16* P, int m, int c) {
    const u32x2 a = *(const u32x2*)(P + (size_t)m * NP + PC_DC + c), b = *(const u32x2*)(P + (size_t)m * NP + PC_DV + c);
    return (f32x4){lo16(a.x) * lo16(b.x), hi16(a.x) * hi16(b.x), lo16(a.y) * lo16(b.y), hi16(a.y) * hi16(b.y)};
}
__device__ __forceinline__ void sc_unit(const Ctx& C0, const bf16* P, bf16* Y, const float* cw, const float* gn, int wu) {
    const Ctx C = relaunder(C0);
    const int c = 4 * C.lane, m0 = 32 * wu, t0 = m0 & (L - 1);
    const f32x4 w0 = *(const f32x4*)(cw + c), w1 = *(const f32x4*)(cw + 256 + c), w2 = *(const f32x4*)(cw + 512 + c), g = *(const f32x4*)(gn + c);
    f32x4 p2 = (f32x4){0.f, 0.f, 0.f, 0.f}, p1 = p2;
    if (t0 > 0) { p2 = sc_cv(P, m0 - 2, c); p1 = sc_cv(P, m0 - 1, c); }
    for (int i = 0; i < 32; ++i) {
        const int m = m0 + i; const f32x4 cv = sc_cv(P, m, c);
        const u32x2 bb = *(const u32x2*)(P + (size_t)m * NP + PC_DB + c);
        const f32x4 bg = (f32x4){lo16(bb.x), hi16(bb.x), lo16(bb.y), hi16(bb.y)};
        const f32x4 y = bg * (w0 * p2 + w1 * p1 + w2 * cv);
        float ss = (y.x * y.x + y.y * y.y) + (y.z * y.z + y.w * y.w);
        ss += __shfl_xor(ss, 1); ss += __shfl_xor(ss, 2); ss += __shfl_xor(ss, 4); ss += __shfl_xor(ss, 8);
        const float rstd = rsqrtf(ss * (1.f / 64.f) + EPS);
        u32x2 w; w.x = pk2(y.x * rstd * g.x, y.y * rstd * g.y); w.y = pk2(y.z * rstd * g.z, y.w * rstd * g.w);
        *(u32x2*)(Y + (size_t)m * D + 768 + c) = w;
        p2 = p1; p1 = cv;
    }
}
__device__ __forceinline__ void foxprep_unit(const Ctx& C0, const bf16* P, bf16* Vt, float* Fraw, const float* bfor, int wu) {
    const Ctx C = relaunder(C0);
    const int lane = C.lane, c = 4 * lane, h = lane >> 4, d = c & 63, m0 = 32 * wu, b = m0 / L, t0 = m0 & (L - 1);
    for (int i8 = 0; i8 < 4; ++i8) {
        u32x2 vraw[8];
#pragma unroll
        for (int j = 0; j < 8; ++j) vraw[j] = *(const u32x2*)(P + (size_t)(m0 + 8 * i8 + j) * NP + PC_BV + c);
        bf16* vrow = Vt + ((size_t)((b * 4 + h) * 64 + d)) * L + t0 + 8 * i8;
        u32x4 e0, e1, e2, e3;
#define FP_LO(a, b) (((a) & 0xffffu) | ((b) << 16))
#define FP_HI(a, b) (((a) >> 16) | ((b) & 0xffff0000u))
        e0.x = FP_LO(vraw[0].x, vraw[1].x); e0.y = FP_LO(vraw[2].x, vraw[3].x); e0.z = FP_LO(vraw[4].x, vraw[5].x); e0.w = FP_LO(vraw[6].x, vraw[7].x);
        e1.x = FP_HI(vraw[0].x, vraw[1].x); e1.y = FP_HI(vraw[2].x, vraw[3].x); e1.z = FP_HI(vraw[4].x, vraw[5].x); e1.w = FP_HI(vraw[6].x, vraw[7].x);
        e2.x = FP_LO(vraw[0].y, vraw[1].y); e2.y = FP_LO(vraw[2].y, vraw[3].y); e2.z = FP_LO(vraw[4].y, vraw[5].y); e2.w = FP_LO(vraw[6].y, vraw[7].y);
        e3.x = FP_HI(vraw[0].y, vraw[1].y); e3.y = FP_HI(vraw[2].y, vraw[3].y); e3.z = FP_HI(vraw[4].y, vraw[5].y); e3.w = FP_HI(vraw[6].y, vraw[7].y);
#undef FP_LO
#undef FP_HI
        *(u32x4*)(vrow) = e0; *(u32x4*)(vrow + L) = e1; *(u32x4*)(vrow + 2 * L) = e2; *(u32x4*)(vrow + 3 * L) = e3;
        if (lane < 32) { const int j = lane >> 2, hh = lane & 3; const int m = m0 + 8 * i8 + j;
            const float f = bf2f(P[(size_t)m * NP + PC_BF + hh]) + bfor[hh];
            Fraw[(size_t)(b * 4 + hh) * L + t0 + 8 * i8 + j] = logsigmoid(f); }
    }
}

constexpr int G_QD = 0, G_KD = 33792, G_VT = 67584, G_GLR = 104448, G_TOT = 108544, G_STG = 110592;
constexpr int GROW = 528, TROW = 144;
__device__ __forceinline__ float gla_la(ldsp GLR, int t, const float (&w2)[16], float bg) {
    float z = bg;
#pragma unroll
    for (int r4 = 0; r4 < 4; ++r4) { const f32x4 gl = lds_ld<f32x4>(GLR, (t * 16 + r4 * 4) * 4); z += gl.x * w2[4 * r4] + gl.y * w2[4 * r4 + 1] + gl.z * w2[4 * r4 + 2] + gl.w * w2[4 * r4 + 3]; }
    const float ls = fminf(z, 0.f) - __logf(1.0f + __expf(-fabsf(z)));
    return ls * (1.f / 16.f);
}
__device__ __forceinline__ void gla_gate(const Ctx& C, ldsp GLR, ldsp TOT, const bf16* P, const float* w2g, const float* bgate, int m0, int c, int th, float (&bb)[32], float& blast) {
    for (int e = C.tid; e < 1024; e += NTHREADS) { const int t = e >> 4, r = e & 15; lds_st<float>(GLR, e * 4, bf2f(P[(size_t)(m0 + t) * NP + PC_ALR + r])); }
    float w2[16];
#pragma unroll
    for (int r = 0; r < 16; ++r) w2[r] = w2g[r * 256 + c];
    const float bg = bgate[c];
    __syncthreads();
    float run = 0.f;
#pragma unroll
    for (int i = 0; i < 32; ++i) { run += gla_la(GLR, 32 * th + i, w2, bg); bb[i] = run; if (i & 1) __builtin_amdgcn_sched_barrier(0); }
    lds_st<float>(TOT, (th * 256 + c) * 4, run);
    __syncthreads();
    const float t0 = lds_ld<float>(TOT, c * 4), t1 = lds_ld<float>(TOT, (256 + c) * 4);
    if (th) {
#pragma unroll
        for (int i = 0; i < 32; ++i) bb[i] += t0;
    }
    blast = t0 + t1;
}
__device__ __forceinline__ void gla_passA(const Ctx& C0, const bf16* P, float* GST, float* GD, const float* w2g, const float* bgate, int unit) {
    const Ctx C = relaunder(C0);
    const int b = unit >> 7, n = unit & 127, m0 = b * L + 64 * n, c = C.tid & 255, th = C.tid >> 8;
    __syncthreads();
    const ldsp QD = lds_opaque(C.lds + G_QD), KD = lds_opaque(C.lds + G_KD), VT_ = lds_opaque(C.lds + G_VT), GLR = lds_opaque(C.lds + G_GLR), TOT = lds_opaque(C.lds + G_TOT);
    bf16 rk[32], rv[32];
#pragma unroll
    for (int i = 0; i < 32; ++i) { const size_t ro = (size_t)(m0 + 32 * th + i) * NP; rk[i] = P[ro + PC_AK + c]; rv[i] = P[ro + PC_AV + c]; }
    float bb[32], blast; gla_gate(C, GLR, TOT, P, w2g, bgate, m0, c, th, bb, blast);
#pragma unroll
    for (int i8 = 0; i8 < 4; ++i8) { float kk[8], vv[8];
#pragma unroll
        for (int j = 0; j < 8; ++j) { kk[j] = bf2f(rk[8 * i8 + j]) * __expf(blast - bb[8 * i8 + j]); vv[j] = bf2f(rv[8 * i8 + j]); }
        lds_st<u32x4>(QD, c * TROW + (32 * th + 8 * i8) * 2, pack8u(kk)); lds_st<u32x4>(VT_, c * TROW + (32 * th + 8 * i8) * 2, pack8u(vv)); }
    if (th == 0) GD[(size_t)((b * 128 + n) * 4 + (c >> 6)) * 64 + (c & 63)] = __expf(blast);
    __syncthreads();
    const int w = C.wave, h = w >> 1, dt = w & 1, r32 = C.lane & 31, hi = C.lane >> 5;
    f32x16 acc[2]; acc[0] = (f32x16){}; acc[1] = (f32x16){};
#pragma unroll
    for (int s = 0; s < 4; ++s) { const bf16x8 bf = lds_ld<bf16x8>(QD, (h * 64 + 32 * dt + r32) * TROW + (16 * s + 8 * hi) * 2);
#pragma unroll
        for (int vt = 0; vt < 2; ++vt) { const bf16x8 af = lds_ld<bf16x8>(VT_, (h * 64 + 32 * vt + r32) * TROW + (16 * s + 8 * hi) * 2); acc[vt] = MFMA32(af, bf, acc[vt]); } }
    float* st = GST + (size_t)((b * 128 + n) * 4 + h) * 4096;
#pragma unroll
    for (int vt = 0; vt < 2; ++vt)
#pragma unroll
        for (int r = 0; r < 16; ++r) st[(32 * vt + crow(r, hi)) * 64 + 32 * dt + r32] = acc[vt][r];
}
__device__ __forceinline__ void gla_passC(const Ctx& C0, const bf16* P, const bf16* GSB, bf16* Y, const float* w2g, const float* bgate, const float* gnorm, int unit) {
    const Ctx C = relaunder(C0);
    const int b = unit >> 7, n = unit & 127, m0 = b * L + 64 * n, c = C.tid & 255, th = C.tid >> 8;
    __syncthreads();
    const ldsp QD = lds_opaque(C.lds + G_QD), KD = lds_opaque(C.lds + G_KD), VT_ = lds_opaque(C.lds + G_VT), GLR = lds_opaque(C.lds + G_GLR), TOT = lds_opaque(C.lds + G_TOT);
    bf16x8 sfr[2][4];
    { const int w_ = C.wave, h_ = w_ >> 1, r32_ = C.lane & 31, hi_ = C.lane >> 5; const bf16* stb = GSB + (size_t)((b * 128 + n) * 4 + h_) * 4096;
#pragma unroll
      for (int vt = 0; vt < 2; ++vt)
#pragma unroll
        for (int s_ = 0; s_ < 4; ++s_) sfr[vt][s_] = *(const bf16x8*)(stb + (32 * vt + r32_) * 64 + 16 * s_ + 8 * hi_); }
    { bf16 rq[32], rk[32], rv[32];
#pragma unroll
      for (int i = 0; i < 32; ++i) { const size_t ro = (size_t)(m0 + 32 * th + i) * NP; rq[i] = P[ro + PC_AQ + c]; rk[i] = P[ro + PC_AK + c]; rv[i] = P[ro + PC_AV + c]; }
      float bb[32], blast; gla_gate(C, GLR, TOT, P, w2g, bgate, m0, c, th, bb, blast);
#pragma unroll
      for (int i8 = 0; i8 < 4; ++i8) { float vv[8];
#pragma unroll
        for (int j = 0; j < 8; ++j) { const int t = 32 * th + 8 * i8 + j; const float e = __expf(bb[8 * i8 + j]), ei = __expf(-bb[8 * i8 + j]);
            const float q = bf2f(rq[8 * i8 + j]) * 0.125f * e, k = bf2f(rk[8 * i8 + j]) * ei; vv[j] = bf2f(rv[8 * i8 + j]);
            lds_st<bf16>(QD, t * GROW + c * 2, f2bf(q)); lds_st<bf16>(KD, t * GROW + c * 2, f2bf(k)); }
        lds_st<u32x4>(VT_, c * TROW + (32 * th + 8 * i8) * 2, pack8u(vv)); } }
    __syncthreads();
    const int w = C.wave, h = w >> 1, ih = w & 1, r32 = C.lane & 31, hi = C.lane >> 5;
    bf16x8 qf[4];
#pragma unroll
    for (int s = 0; s < 4; ++s) qf[s] = lds_ld<bf16x8>(QD, (32 * ih + r32) * GROW + (h * 64 + 16 * s + 8 * hi) * 2);
    f32x16 o[2]; o[0] = (f32x16){}; o[1] = (f32x16){};
    u32x4 gpre[4];
#pragma unroll
    for (int it = 0; it < 4; ++it) gpre[it] = *(const u32x4*)(P + (size_t)(m0 + 32 * ih + 8 * it + (C.lane >> 3)) * NP + PC_AG + h * 64 + 8 * (C.lane & 7));
#pragma unroll
    for (int vt = 0; vt < 2; ++vt)
#pragma unroll
        for (int s = 0; s < 4; ++s) o[vt] = MFMA32(sfr[vt][s], qf[s], o[vt]);
    for (int jt = 0; jt <= ih; ++jt) {
        f32x16 X = (f32x16){};
#pragma unroll
        for (int s = 0; s < 4; ++s) { const bf16x8 kf = lds_ld<bf16x8>(KD, (32 * jt + r32) * GROW + (h * 64 + 16 * s + 8 * hi) * 2); X = MFMA32(kf, qf[s], X); }
        if (jt == ih) {
#pragma unroll
            for (int r = 0; r < 16; ++r) if (crow(r, hi) > r32) X[r] = 0.f;
        }
#pragma unroll
        for (int s2 = 0; s2 < 2; ++s2) { const bf16x8 pf = pack8(X[8 * s2], X[8 * s2 + 1], X[8 * s2 + 2], X[8 * s2 + 3], X[8 * s2 + 4], X[8 * s2 + 5], X[8 * s2 + 6], X[8 * s2 + 7]);
#pragma unroll
            for (int vt = 0; vt < 2; ++vt) { const int ao = (h * 64 + 32 * vt + r32) * TROW + (32 * jt + 16 * s2 + 4 * hi) * 2;
                const bf16x8 af = cat2(lds_ld<u32x2>(VT_, ao), lds_ld<u32x2>(VT_, ao + 16)); o[vt] = MFMA32(af, pf, o[vt]); } }
    }
    ldsp stg = C.lds + G_STG + w * STG_BYTES;
    stage_write(stg, o, r32, hi);
    asm volatile("s_waitcnt lgkmcnt(0)" ::: "memory");
#pragma unroll
    for (int it = 0; it < 4; ++it) { const int row = 8 * it + (C.lane >> 3), ch = 8 * (C.lane & 7); const int m = m0 + 32 * ih + row;
        float y[8], gt[8], gn[8]; unpack8(lds_ld<u32x4>(stg, row * STG_ROW + ch * 2), y); unpack8(gpre[it], gt); load8f(gnorm + h * 64 + ch, gn);
        float ss = 0.f;
#pragma unroll
        for (int e = 0; e < 8; ++e) ss += y[e] * y[e];
        ss += __shfl_xor(ss, 1); ss += __shfl_xor(ss, 2); ss += __shfl_xor(ss, 4);
        const float rstd = rsqrtf(ss * (1.f / 64.f) + EPS);
#pragma unroll
        for (int e = 0; e < 8; ++e) y[e] = y[e] * rstd * gn[e] * silu(gt[e]);
        *(u32x4*)(Y + (size_t)m * D + h * 64 + ch) = pack8u(y); }
}

constexpr int S_B = 0, S_C = 34816, S_X = 69632, S_AS = 104448, S_DT = 105472, S_ACS = 106496, S_SSX = 107520, S_STG = 108544;
constexpr int SROW = 272;
__device__ __forceinline__ void ssd_dt(const Ctx& C, ldsp SM, const bf16* P, const float* dtb, const float* Alog, int m0, int g) {
    const int hh = (C.tid >> 7) & 1, j = C.tid & 127;
    if (C.tid < 256) { const int h = 2 * g + hh; const float dtv = softplus(bf2f(P[(size_t)(m0 + j) * NP + PC_DT + h]) + dtb[h]);
        lds_st<float>(SM, (S_DT - S_AS) + (hh * 128 + j) * 4, dtv); lds_st<float>(SM, (S_AS - S_AS) + (hh * 128 + j) * 4, -__expf(Alog[h]) * dtv); }
    __syncthreads();
    if (C.tid < 256) { float v = lds_ld<float>(SM, (S_AS - S_AS) + (hh * 128 + j) * 4);
#pragma unroll
        for (int o_ = 1; o_ < 64; o_ <<= 1) { const float t_ = __shfl_up(v, o_); if (C.lane >= o_) v += t_; }
        if ((j & 64) == 0 && C.lane == 63) lds_st<float>(SM, (S_SSX - S_AS) + hh * 4, v);
        lds_st<float>(SM, (S_ACS - S_AS) + (hh * 128 + j) * 4, v); }
    __syncthreads();
    if (C.tid < 256 && (j & 64)) lds_st<float>(SM, (S_ACS - S_AS) + (hh * 128 + j) * 4, lds_ld<float>(SM, (S_ACS - S_AS) + (hh * 128 + j) * 4) + lds_ld<float>(SM, (S_SSX - S_AS) + hh * 4));
    __syncthreads();
}
template <bool PASS_C>
__device__ __forceinline__ void ssd_issue(const Ctx& C, const bf16* P, int m0, int n, int g, bf16 (&rawa)[PASS_C ? 3 : 2][35]) {
    constexpr int NCH = PASS_C ? 384 : 256, NIT = PASS_C ? 3 : 2;
#pragma unroll
    for (int k = 0; k < NIT; ++k) {
        const int item = C.tid + NTHREADS * k, ch = item % NCH, tq = item / NCH, typ = ch >> 7, cc = ch & 127, ci = typ * 256 + g * 128 + cc, pcol = PC_XBC + ci, j0 = 32 * tq;
        const bf16* pp = P + ((ptrdiff_t)(m0 + j0) - 3) * NP + pcol; const bool hasprev = (128 * n + j0 > 0);
#pragma unroll
        for (int t_ = 0; t_ < 35; ++t_) rawa[k][t_] = (t_ >= 3 || hasprev) ? pp[(ptrdiff_t)t_ * NP] : (bf16)0;
    }
}
template <bool PASS_C>
__device__ __forceinline__ void ssd_load(const Ctx& C, ldsp SB, ldsp SC, ldsp SX, ldsp SM, const bf16 (&rawa)[PASS_C ? 3 : 2][35], bf16* XS, const float* cw, const float* cb, int m0, int n, int g) {
    constexpr int NCH = PASS_C ? 384 : 256, NIT = PASS_C ? 3 : 2;
#pragma unroll
    for (int k = 0; k < NIT; ++k) {
        const int item = C.tid + NTHREADS * k, ch = item % NCH, tq = item / NCH, typ = ch >> 7, cc = ch & 127, ci = typ * 256 + g * 128 + cc;
        const float w0 = cw[ci], w1 = cw[768 + ci], w2 = cw[1536 + ci], w3 = cw[2304 + ci], bias = cb[ci];
        const int j0 = 32 * tq, hh = cc >> 6;
        const bf16 (&raw)[35] = rawa[k];
        float u3 = bf2f(raw[0]), u2 = bf2f(raw[1]), u1 = bf2f(raw[2]);
        const float alast = lds_ld<float>(SM, (S_ACS - S_AS) + (hh * 128 + 127) * 4);
#pragma unroll
        for (int i8 = 0; i8 < 4; ++i8) { float yv[8];
#pragma unroll
            for (int j = 0; j < 8; ++j) { const float u0 = bf2f(raw[3 + 8 * i8 + j]);
                yv[j] = silu(w0 * u3 + w1 * u2 + w2 * u1 + w3 * u0 + bias); u3 = u2; u2 = u1; u1 = u0; }
            const int jb = j0 + 8 * i8;
            if (typ == 0) {
#pragma unroll
                for (int j = 0; j < 8; ++j) { const float dtv = lds_ld<float>(SM, (S_DT - S_AS) + (hh * 128 + jb + j) * 4);
                    if (!PASS_C) { XS[(size_t)(m0 + jb + j) * 256 + g * 128 + cc] = f2bf(yv[j]); yv[j] *= dtv * __expf(alast - lds_ld<float>(SM, (S_ACS - S_AS) + (hh * 128 + jb + j) * 4)); }
                    else yv[j] *= dtv; }
                lds_st<u32x4>(SX, cc * SROW + jb * 2, pack8u(yv));
            } else if (!PASS_C) { lds_st<u32x4>(SB, cc * SROW + jb * 2, pack8u(yv)); }
            else { const ldsp base = (typ == 1) ? SB : SC;
#pragma unroll
                for (int j = 0; j < 8; ++j) lds_st<bf16>(base, (jb + j) * SROW + cc * 2, f2bf(yv[j])); }
        }
    }
}
__device__ __forceinline__ void ssd_passA(const Ctx& C0, const bf16* P, bf16* XS, float* SST, float* SD, const float* cw, const float* cb, const float* dtb, const float* Alog, int unit) {
    const Ctx C = relaunder(C0);
    const int b = unit >> 7, n = (unit >> 1) & 63, g = unit & 1, m0 = b * L + 128 * n;
    __syncthreads();
    const ldsp SB = lds_opaque(C.lds + S_B), SC = lds_opaque(C.lds + S_C), SX = lds_opaque(C.lds + S_X), SM = lds_opaque(C.lds + S_AS);
    bf16 rawa[2][35]; ssd_issue<false>(C, P, m0, n, g, rawa);
    ssd_dt(C, SM, P, dtb, Alog, m0, g);
    ssd_load<false>(C, SB, SC, SX, SM, rawa, XS, cw, cb, m0, n, g);
    if (C.tid < 2) SD[(size_t)(b * 64 + n) * 4 + 2 * g + C.tid] = __expf(lds_ld<float>(SM, (S_ACS - S_AS) + (C.tid * 128 + 127) * 4));
    __syncthreads();
    const int w = C.wave, hh = w >> 2, nt = w & 3, r32 = C.lane & 31, hi = C.lane >> 5;
    f32x16 acc[2]; acc[0] = (f32x16){}; acc[1] = (f32x16){};
#pragma unroll
    for (int s = 0; s < 8; ++s) { const bf16x8 bf = lds_ld<bf16x8>(SB, (32 * nt + r32) * SROW + (16 * s + 8 * hi) * 2);
#pragma unroll
        for (int pt = 0; pt < 2; ++pt) { const bf16x8 af = lds_ld<bf16x8>(SX, (hh * 64 + 32 * pt + r32) * SROW + (16 * s + 8 * hi) * 2); acc[pt] = MFMA32(af, bf, acc[pt]); } }
    float* st = SST + (size_t)((b * 64 + n) * 4 + 2 * g + hh) * 8192;
#pragma unroll
    for (int pt = 0; pt < 2; ++pt)
#pragma unroll
        for (int r = 0; r < 16; ++r) st[(32 * pt + crow(r, hi)) * 128 + 32 * nt + r32] = acc[pt][r];
}
__device__ __forceinline__ void ssd_passC(const Ctx& C0, const bf16* P, const bf16* XS, const bf16* SSB, bf16* Y, const float* cw, const float* cb, const float* dtb, const float* Alog, const float* Dsk, const float* gnorm, int unit) {
    const Ctx C = relaunder(C0);
    const int b = unit >> 7, n = (unit >> 1) & 63, g = unit & 1, m0 = b * L + 128 * n;
    __syncthreads();
    const ldsp SB = lds_opaque(C.lds + S_B), SC = lds_opaque(C.lds + S_C), SX = lds_opaque(C.lds + S_X), SM = lds_opaque(C.lds + S_AS);
    bf16x8 sfr[2][8];
    { const int w_ = C.wave, hh_ = w_ >> 2, r32_ = C.lane & 31, hi_ = C.lane >> 5; const bf16* stb = SSB + (size_t)((b * 64 + n) * 4 + 2 * g + hh_) * 8192;
#pragma unroll
      for (int pt = 0; pt < 2; ++pt)
#pragma unroll
        for (int s_ = 0; s_ < 8; ++s_) sfr[pt][s_] = *(const bf16x8*)(stb + (32 * pt + r32_) * 128 + 16 * s_ + 8 * hi_); }
    bf16 rawa[3][35]; ssd_issue<true>(C, P, m0, n, g, rawa);
    ssd_dt(C, SM, P, dtb, Alog, m0, g);
    ssd_load<true>(C, SB, SC, SX, SM, rawa, nullptr, cw, cb, m0, n, g);
    __syncthreads();
    const int w = C.wave, hh = w >> 2, it = w & 3, r32 = C.lane & 31, hi = C.lane >> 5, h = 2 * g + hh;
    const float acs_i = lds_ld<float>(SM, (S_ACS - S_AS) + (hh * 128 + 32 * it + r32) * 4);
    f32x16 o[2]; o[0] = (f32x16){}; o[1] = (f32x16){};
    u32x4 xpre[4], zpre[4];
#pragma unroll
    for (int q4 = 0; q4 < 4; ++q4) { const int m_ = m0 + 32 * it + 8 * q4 + (C.lane >> 3); const int ch_ = 8 * (C.lane & 7);
        xpre[q4] = *(const u32x4*)(XS + (size_t)m_ * 256 + g * 128 + hh * 64 + ch_); zpre[q4] = *(const u32x4*)(P + (size_t)m_ * NP + PC_CZ + g * 128 + hh * 64 + ch_); }
#pragma unroll
    for (int s = 0; s < 8; ++s) { const bf16x8 cf = lds_ld<bf16x8>(SC, (32 * it + r32) * SROW + (16 * s + 8 * hi) * 2);
#pragma unroll
        for (int pt = 0; pt < 2; ++pt) o[pt] = MFMA32(sfr[pt][s], cf, o[pt]); }
    { const float ei = __expf(acs_i);
#pragma unroll
      for (int r = 0; r < 16; ++r) { o[0][r] *= ei; o[1][r] *= ei; } }
    for (int jt = 0; jt <= it; ++jt) {
        f32x16 X = (f32x16){};
#pragma unroll
        for (int s = 0; s < 8; ++s) { const bf16x8 bf = lds_ld<bf16x8>(SB, (32 * jt + r32) * SROW + (16 * s + 8 * hi) * 2);
            const bf16x8 cf = lds_ld<bf16x8>(SC, (32 * it + r32) * SROW + (16 * s + 8 * hi) * 2); X = MFMA32(bf, cf, X); }
#pragma unroll
        for (int r = 0; r < 16; ++r) { const int jl = 32 * jt + crow(r, hi); const float aj = lds_ld<float>(SM, (S_ACS - S_AS) + (hh * 128 + jl) * 4);
            X[r] = (jl <= 32 * it + r32) ? X[r] * __expf(acs_i - aj) : 0.f; }
#pragma unroll
        for (int s2 = 0; s2 < 2; ++s2) { const bf16x8 pf = pack8(X[8 * s2], X[8 * s2 + 1], X[8 * s2 + 2], X[8 * s2 + 3], X[8 * s2 + 4], X[8 * s2 + 5], X[8 * s2 + 6], X[8 * s2 + 7]);
#pragma unroll
            for (int pt = 0; pt < 2; ++pt) { const int ao = (hh * 64 + 32 * pt + r32) * SROW + (32 * jt + 16 * s2 + 4 * hi) * 2;
                const bf16x8 af = cat2(lds_ld<u32x2>(SX, ao), lds_ld<u32x2>(SX, ao + 16)); o[pt] = MFMA32(af, pf, o[pt]); } }
    }
    ldsp stg = C.lds + S_STG + w * STG_BYTES;
    stage_write(stg, o, r32, hi);
    asm volatile("s_waitcnt lgkmcnt(0)" ::: "memory");
    float yy[4][8]; const float Dh = Dsk[h]; const int ch = 8 * (C.lane & 7);
#pragma unroll
    for (int q4 = 0; q4 < 4; ++q4) { const int row = 8 * q4 + (C.lane >> 3); const int m = m0 + 32 * it + row;
        float xs[8], z[8]; unpack8(lds_ld<u32x4>(stg, row * STG_ROW + ch * 2), yy[q4]); unpack8(xpre[q4], xs); unpack8(zpre[q4], z);
        float ss = 0.f;
#pragma unroll
        for (int e = 0; e < 8; ++e) { yy[q4][e] = (yy[q4][e] + xs[e] * Dh) * silu(z[e]); ss += yy[q4][e] * yy[q4][e]; }
        ss += __shfl_xor(ss, 1); ss += __shfl_xor(ss, 2); ss += __shfl_xor(ss, 4);
        if ((C.lane & 7) == 0) lds_st<float>(SM, (S_SSX - S_AS) + ((hh * 4 + it) * 32 + row) * 4, ss); }
    __syncthreads();
    float gn[8]; load8f(gnorm + g * 128 + hh * 64 + ch, gn);
#pragma unroll
    for (int q4 = 0; q4 < 4; ++q4) { const int row = 8 * q4 + (C.lane >> 3); const int m = m0 + 32 * it + row;
        const float ss = lds_ld<float>(SM, (S_SSX - S_AS) + ((0 * 4 + it) * 32 + row) * 4) + lds_ld<float>(SM, (S_SSX - S_AS) + ((1 * 4 + it) * 32 + row) * 4);
        const float rstd = rsqrtf(ss * (1.f / 128.f) + EPS);
#pragma unroll
        for (int e = 0; e < 8; ++e) yy[q4][e] = yy[q4][e] * rstd * gn[e];
        *(u32x4*)(Y + (size_t)m * D + 512 + g * 128 + hh * 64 + ch) = pack8u(yy[q4]); }
}

constexpr int F_FS = 0, F_BUF = 32768, F_KROW = 144, F_VROW = 400, F_KB = 192 * F_KROW, F_BUFB = F_KB + 64 * F_VROW, F_STG = F_BUF, F_FLAG = F_BUF + 2 * F_BUFB;
__device__ __forceinline__ u32x4 fox_knorm(u32x4 raw, const float (&g)[8]) {
    float v[8]; unpack8(raw, v); float ss = 0.f;
#pragma unroll
    for (int e = 0; e < 8; ++e) ss += v[e] * v[e];
    ss += __shfl_xor(ss, 1); ss += __shfl_xor(ss, 2); ss += __shfl_xor(ss, 4);
    const float r = rsqrtf(ss * (1.f / 64.f) + EPS);
#pragma unroll
    for (int e = 0; e < 8; ++e) v[e] = v[e] * r * g[e];
    return pack8u(v);
}
__device__ __forceinline__ void fox_attn_unit(const Ctx& C0, const bf16* P, const bf16* Vt, const float* Fl, bf16* Y, const float* qn, const float* kn, const float* on, int unit) {
    const Ctx C = relaunder(C0);
    const int bh = unit >> 5, qb = unit & 31, b = bh >> 2, h = bh & 3, q0 = qb * 256, nk = q0 + 256, w = C.wave, r32 = C.lane & 31, hi = C.lane >> 5;
    __syncthreads();
    const float* Flg = Fl + (size_t)bh * L;
    { f32x4 fv[4];
#pragma unroll
      for (int k = 0; k < 4; ++k) { const int i = 4 * C.tid + 4 * NTHREADS * k; if (i < nk) fv[k] = *(const f32x4*)(Flg + i); }
#pragma unroll
      for (int k = 0; k < 4; ++k) { const int i = 4 * C.tid + 4 * NTHREADS * k; if (i < nk) lds_st<f32x4>(C.lds, F_FS + i * 4, fv[k]); } }
    float gm = fabsf(qn[C.lane]), km = fabsf(kn[C.lane]);
#pragma unroll
    for (int o_ = 1; o_ < 64; o_ <<= 1) { gm = fmaxf(gm, __shfl_xor(gm, o_)); km = fmaxf(km, __shfl_xor(km, o_)); }
    __syncthreads();
    const int q0w = q0 + 32 * w, ktlast = (q0w + 31) >> 6, ktlast_b = 4 * qb + 3;
    const float TH = 16.f * LOG2E * gm * km + 64.f;
    int lo, lo_b;
    { const float Fq0 = lds_ld<float>(C.lds, F_FS + q0w * 4); int a_ = 0, hb = ktlast;
      while (a_ < hb) { const int mid = (a_ + hb) >> 1; if (Fq0 - lds_ld<float>(C.lds, F_FS + (64 * mid + 63) * 4) >= -TH) hb = mid; else a_ = mid + 1; } lo = a_; }
    { const float Fq0 = lds_ld<float>(C.lds, F_FS + q0 * 4); int a_ = 0, hb = q0 >> 6;
      while (a_ < hb) { const int mid = (a_ + hb) >> 1; if (Fq0 - lds_ld<float>(C.lds, F_FS + (64 * mid + 63) * 4) >= -TH) hb = mid; else a_ = mid + 1; } lo_b = a_; }
    const float Flq = lds_ld<float>(C.lds, F_FS + (q0w + r32) * 4);
    const size_t mb = (size_t)b * L;
    bf16x8 qr[4];
    { u32x4 qraw[4]; float qv[4][8], qg[4][8]; float ss = 0.f;
#pragma unroll
      for (int d0 = 0; d0 < 4; ++d0) { qraw[d0] = *(const u32x4*)(P + (mb + q0w + r32) * NP + PC_BQ + h * 64 + 16 * d0 + 8 * hi); load8f(qn + 16 * d0 + 8 * hi, qg[d0]); }
#pragma unroll
      for (int d0 = 0; d0 < 4; ++d0) { unpack8(qraw[d0], qv[d0]);
#pragma unroll
        for (int e = 0; e < 8; ++e) ss += qv[d0][e] * qv[d0][e]; }
      ss += __shfl_xor(ss, 32);
      const float rq = rsqrtf(ss * (1.f / 64.f) + EPS) * (0.125f * LOG2E);
#pragma unroll
      for (int d0 = 0; d0 < 4; ++d0) {
#pragma unroll
        for (int e = 0; e < 8; ++e) qv[d0][e] = qv[d0][e] * rq * qg[d0][e];
        qr[d0] = __builtin_bit_cast(bf16x8, pack8u(qv[d0])); } }
    float kg8[8]; load8f(kn + (C.tid & 7) * 8, kg8);
    float mrun = -INFINITY, lrun = 0.f; f32x16 o[2]; o[0] = (f32x16){}; o[1] = (f32x16){};
    const int qrow = q0w + r32;
    const int nch = (ktlast_b - lo_b + 3) / 3;
    u32x4 st[6];
    const bf16* kg = P + (mb + (C.tid >> 3)) * NP + PC_BK + h * 64 + (C.tid & 7) * 8;
    const int vd = C.tid / 24, vs = C.tid % 24;
    const ldsp BUF = lds_opaque(C.lds + F_BUF);
#define FOX_LOAD(c_) do { const int kt0_ = lo_b + 3 * (c_); \
        _Pragma("unroll") for (int i = 0; i < 3; ++i) { if (kt0_ + i <= ktlast_b) st[i] = *(const u32x4*)(kg + (size_t)(64 * (kt0_ + i)) * NP); } \
        _Pragma("unroll") for (int i = 0; i < 3; ++i) { const int p_ = C.tid + 512 * i, d_ = p_ / 24, sg_ = p_ % 24; if (kt0_ + (sg_ >> 3) <= ktlast_b) st[3 + i] = *(const u32x4*)(Vt + ((size_t)(bh * 64 + d_)) * L + 64 * kt0_ + sg_ * 8); } } while (0)
#define FOX_STORE(c_, par_) do { const int kt0_ = lo_b + 3 * (c_); const int bo_ = ((par_) & 1) * F_BUFB; \
        _Pragma("unroll") for (int i = 0; i < 3; ++i) { if (kt0_ + i <= ktlast_b) lds_st<u32x4>(BUF, bo_ + ((C.tid >> 3) + 64 * i) * F_KROW + (C.tid & 7) * 16, fox_knorm(st[i], kg8)); } \
        _Pragma("unroll") for (int i = 0; i < 3; ++i) { const int p_ = C.tid + 512 * i, d_ = p_ / 24, sg_ = p_ % 24; if (kt0_ + (sg_ >> 3) <= ktlast_b) lds_st<u32x4>(BUF, bo_ + F_KB + d_ * F_VROW + sg_ * 16, st[3 + i]); } } while (0)
    (void)vd; (void)vs;
    const float qkb = 8.f * LOG2E * gm * km;
    if (C.tid == 0) lds_st<unsigned>(C.lds, F_FLAG, 0u);
    FOX_LOAD(nch - 1); FOX_STORE(nch - 1, 0);
    __syncthreads();
    bool active = true;
    for (int ci = 0; ci < nch; ++ci) {
        const int c = nch - 1 - ci;
        if (c > 0) FOX_LOAD(c - 1);
        const int bo = (ci & 1) * F_BUFB;
        for (int tl = 2; tl >= 0; --tl) {
            const int kt = lo_b + 3 * c + tl;
            if (!active || kt > ktlast) continue;
            if (kt < lo || __all(qkb + (Flq - lds_ld<float>(C.lds, F_FS + (64 * kt + 63) * 4)) < mrun - 48.f)) {
                active = false; if (C.lane == 0) __hip_atomic_fetch_add((LAS unsigned*)(C.lds + F_FLAG), 1u, __ATOMIC_RELAXED, __HIP_MEMORY_SCOPE_WORKGROUP); continue; }
            const int kbase = bo + (64 * tl + r32) * F_KROW + 16 * hi;
            f32x16 s0 = (f32x16){}, s1 = (f32x16){};
#pragma unroll
            for (int d0 = 0; d0 < 4; ++d0) { const bf16x8 k0 = lds_ld<bf16x8>(BUF, kbase + 32 * d0), k1 = lds_ld<bf16x8>(BUF, kbase + 32 * F_KROW + 32 * d0); s0 = MFMA32(k0, qr[d0], s0); s1 = MFMA32(k1, qr[d0], s1); }
#pragma unroll
            for (int g = 0; g < 4; ++g) { const f32x4 fa = lds_ld<f32x4>(C.lds, F_FS + (64 * kt + 8 * g + 4 * hi) * 4), fb = lds_ld<f32x4>(C.lds, F_FS + (64 * kt + 32 + 8 * g + 4 * hi) * 4);
                s0[4 * g] += Flq - fa.x; s0[4 * g + 1] += Flq - fa.y; s0[4 * g + 2] += Flq - fa.z; s0[4 * g + 3] += Flq - fa.w;
                s1[4 * g] += Flq - fb.x; s1[4 * g + 1] += Flq - fb.y; s1[4 * g + 2] += Flq - fb.z; s1[4 * g + 3] += Flq - fb.w; }
            if (64 * kt + 63 > q0w) {
#pragma unroll
                for (int r = 0; r < 16; ++r) { const int key = 64 * kt + crow(r, hi); if (key > qrow) s0[r] = -INFINITY; if (key + 32 > qrow) s1[r] = -INFINITY; }
            }
            float mx = fmaxf(s0[0], s1[0]);
#pragma unroll
            for (int r = 1; r < 16; ++r) mx = fmaxf(mx, fmaxf(s0[r], s1[r]));
            mx = fmaxf(mx, __shfl_xor(mx, 32));
            const float mnew = fmaxf(mrun, mx), alpha = __builtin_amdgcn_exp2f(mrun - mnew); mrun = mnew;
            float rs = 0.f;
#pragma unroll
            for (int r = 0; r < 16; ++r) { s0[r] = __builtin_amdgcn_exp2f(s0[r] - mnew); s1[r] = __builtin_amdgcn_exp2f(s1[r] - mnew); rs += s0[r] + s1[r]; }
            lrun = lrun * alpha + rs;
#pragma unroll
            for (int r = 0; r < 16; ++r) { o[0][r] *= alpha; o[1][r] *= alpha; }
            const int vbase = bo + F_KB + r32 * F_VROW + (64 * tl + 4 * hi) * 2;
#pragma unroll
            for (int s2 = 0; s2 < 2; ++s2) {
                const bf16x8 p0 = pack8(s0[8 * s2], s0[8 * s2 + 1], s0[8 * s2 + 2], s0[8 * s2 + 3], s0[8 * s2 + 4], s0[8 * s2 + 5], s0[8 * s2 + 6], s0[8 * s2 + 7]);
                const bf16x8 p1 = pack8(s1[8 * s2], s1[8 * s2 + 1], s1[8 * s2 + 2], s1[8 * s2 + 3], s1[8 * s2 + 4], s1[8 * s2 + 5], s1[8 * s2 + 6], s1[8 * s2 + 7]);
#pragma unroll
                for (int dt = 0; dt < 2; ++dt) { const int vo = vbase + dt * 32 * F_VROW + 32 * s2;
                    const bf16x8 a0 = cat2(lds_ld<u32x2>(BUF, vo), lds_ld<u32x2>(BUF, vo + 16)), a1 = cat2(lds_ld<u32x2>(BUF, vo + 64), lds_ld<u32x2>(BUF, vo + 80));
                    o[dt] = MFMA32(a0, p0, o[dt]); o[dt] = MFMA32(a1, p1, o[dt]); }
            }
        }
        if (c > 0) FOX_STORE(c - 1, ci + 1);
        __syncthreads();
        if (lds_ld<unsigned>(C.lds, F_FLAG) >= 8u) break;
    }
    __syncthreads();
#undef FOX_LOAD
#undef FOX_STORE
    const float ltot = lrun + __shfl_xor(lrun, 32), inv = 1.0f / ltot;
#pragma unroll
    for (int r = 0; r < 16; ++r) { o[0][r] *= inv; o[1][r] *= inv; }
    ldsp stg = C.lds + F_STG + w * STG_BYTES;
    stage_write(stg, o, r32, hi);
    asm volatile("s_waitcnt lgkmcnt(0)" ::: "memory");
#pragma unroll
    for (int it = 0; it < 4; ++it) { const int row = 8 * it + (C.lane >> 3), ch = 8 * (C.lane & 7); const size_t m = mb + q0w + row;
        float y[8], gn[8]; unpack8(lds_ld<u32x4>(stg, row * STG_ROW + ch * 2), y); load8f(on + h * 64 + ch, gn);
        float ss = 0.f;
#pragma unroll
        for (int e = 0; e < 8; ++e) ss += y[e] * y[e];
        ss += __shfl_xor(ss, 1); ss += __shfl_xor(ss, 2); ss += __shfl_xor(ss, 4);
        const float rstd = rsqrtf(ss * (1.f / 64.f) + EPS);
#pragma unroll
        for (int e = 0; e < 8; ++e) y[e] = y[e] * rstd * gn[e];
        *(u32x4*)(Y + m * D + 256 + h * 64 + ch) = pack8u(y); }
}

__device__ __forceinline__ void scan_phase(const Ctx& C, const float* GST, const float* GD, bf16* GSB, const float* SST, const float* SD, bf16* SSB, const float* Fraw, float* Fl) {
    if (C.tid < 256) {
    for (int e = C.blk * 256 + C.tid; e < 65536; e += C.nblk * 256) { const int b = e >> 14, h = (e >> 12) & 3, vd = e & 4095, d = vd & 63;
        const float* p = GST + ((size_t)(b * 128) * 4 + h) * 4096 + vd; bf16* pb = GSB + ((size_t)(b * 128) * 4 + h) * 4096 + vd; const float* dp = GD + ((size_t)(b * 128) * 4 + h) * 64 + d; float S = 0.f;
        for (int n0 = 0; n0 < 128; n0 += 32) { float kv[32], dc[32];
#pragma unroll
            for (int j = 0; j < 32; ++j) { kv[j] = p[(size_t)(n0 + j) * 16384]; dc[j] = dp[(n0 + j) * 256]; }
#pragma unroll
            for (int j = 0; j < 32; ++j) { pb[(size_t)(n0 + j) * 16384] = f2bf(S); S = S * dc[j] + kv[j]; } } }
    } else {
    for (int e = C.blk * 256 + (C.tid - 256); e < 131072; e += C.nblk * 256) { const int b = e >> 15, h = (e >> 13) & 3, pn = e & 8191;
        const float* p = SST + ((size_t)(b * 64) * 4 + h) * 8192 + pn; bf16* pb = SSB + ((size_t)(b * 64) * 4 + h) * 8192 + pn; const float* dp = SD + (size_t)(b * 64) * 4 + h; float S = 0.f;
        for (int n0 = 0; n0 < 64; n0 += 32) { float kv[32], dc[32];
#pragma unroll
            for (int j = 0; j < 32; ++j) { kv[j] = p[(size_t)(n0 + j) * 32768]; dc[j] = dp[(n0 + j) * 4]; }
#pragma unroll
            for (int j = 0; j < 32; ++j) { pb[(size_t)(n0 + j) * 32768] = f2bf(S); S = S * dc[j] + kv[j]; } } }
    }
    for (int bh = C.blk; bh < 16; bh += C.nblk) {
        __syncthreads();
        const float* src = Fraw + (size_t)bh * L + 16 * C.tid; float v[16]; float run = 0.f;
#pragma unroll
        for (int j4 = 0; j4 < 4; ++j4) { const f32x4 a = *(const f32x4*)(src + 4 * j4); run += a.x; v[4 * j4] = run; run += a.y; v[4 * j4 + 1] = run; run += a.z; v[4 * j4 + 2] = run; run += a.w; v[4 * j4 + 3] = run; }
        float incl = run;
#pragma unroll
        for (int o_ = 1; o_ < 64; o_ <<= 1) { const float t_ = __shfl_up(incl, o_); if (C.lane >= o_) incl += t_; }
        if (C.lane == 63) lds_st<float>(C.lds, C.wave * 4, incl);
        __syncthreads();
        float pre = incl - run;
        for (int w_ = 0; w_ < C.wave; ++w_) pre += lds_ld<float>(C.lds, w_ * 4);
        float* dst = Fl + (size_t)bh * L + 16 * C.tid;
#pragma unroll
        for (int j4 = 0; j4 < 4; ++j4) *(f32x4*)(dst + 4 * j4) = (f32x4){(pre + v[4 * j4]) * LOG2E, (pre + v[4 * j4 + 1]) * LOG2E, (pre + v[4 * j4 + 2]) * LOG2E, (pre + v[4 * j4 + 3]) * LOG2E};
    }
}

#ifndef MK_PER_PHASE
#define MK_PER_PHASE 0
#endif
#ifndef PH_MASK
#define PH_MASK 0xffff
#endif
#define EN(k) ((PH_MASK >> (k)) & 1)
#ifndef DUP
#define DUP 0
#endif
#define DUPN(k) (((DUP >> (k)) & 1) ? 2 : 1)
#ifndef DUPT
#define DUPT -1
#endif
#define REPT(k) for (int rt_ = 0; rt_ < ((DUPT == (k)) ? 2 : 1); ++rt_)
constexpr int NPHASE = 1 + 9 * NLAYER;

__global__ void __launch_bounds__(NTHREADS) mega(Args a) {
    extern __shared__ __attribute__((aligned(16))) unsigned char lds_raw[];
    cg::grid_group grid = cg::this_grid();
    LAS unsigned char* glds = (LAS unsigned char*)lds_raw;
    float* X = a.out;
    volatile LAS unsigned* bst = (volatile LAS unsigned*)((ldsp)lds_raw + LDS_BYTES - 64);
    if (threadIdx.x < 16) bst[threadIdx.x] = 0u;
    __syncthreads();
    XcdBarrier bar = xcd_barrier_post((unsigned*)a.ws, bst); unsigned nbar = 0u;

    if (a.ph_hi < 0) grid.sync();
    for (int ph = a.ph_lo; ph < a.ph_hi; ++ph) {
        Ctx C; { int tid_ = threadIdx.x, blk_ = blockIdx.x, nblk_ = gridDim.x; unsigned char* ws_ = a.ws;
            asm volatile("" : "+v"(tid_)); asm volatile("" : "+s"(blk_), "+s"(nblk_), "+s"(ws_));
            C.ws = ws_; C.lds = (ldsp)lds_raw; C.tid = tid_; C.lane = tid_ & 63; C.wave = __builtin_amdgcn_readfirstlane(tid_ >> 6); C.nblk = nblk_; C.blk = blk_; }
        unsigned char* ws = C.ws;
        bf16* XN = (bf16*)(ws + WS_XN); bf16* HP = (bf16*)(ws + WS_HP); bf16* VT = (bf16*)(ws + WS_VT); bf16* YB = (bf16*)X; bf16* GSB = (bf16*)((unsigned char*)X + 64 * MiB); bf16* SSB = (bf16*)((unsigned char*)X + 80 * MiB);
        float* GST = (float*)(ws + WS_GST); float* GD = (float*)(ws + WS_GD); float* SST = (float*)(ws + WS_SST); float* SD = (float*)(ws + WS_SD);
        float* FRAW = (float*)(ws + WS_FRAW); float* FL = (float*)(ws + WS_FL); bf16* XS = (bf16*)(ws + WS_XS); unsigned long long* RS = (unsigned long long*)(ws + WS_RS);
        if (ph == 0) {
            for (int rep = 0; rep < DUPN(6); ++rep) { if (EN(0)) prologue(C, a); }
            for (int i = C.blk * NTHREADS + C.tid; i < (NLAYER * 3 - 1) * M / 2; i += C.nblk * NTHREADS) ((u32x4*)(RS + M))[i] = (u32x4){0u, 0u, 0u, 0u};
            norm_phase(C, in_ptr(a, 0), XN, RS);
        } else {
            const int q = ph - 1, l = q / 9, s = q % 9;
            unsigned char* wb = ws + WS_W + (size_t)l * W_LSTRIDE;
            if (s == 0 || s == 7) {
                pg8::Gemm g{XN, (const bf16*)(wb + (s == 0 ? WO_1U : WO_2U)), M, NUP, D}; pg8::StaticOrder S; S.init(M, NUP, C.nblk, C.blk);
                pg8::EpiSwiglu E{HP, FF, RS + (size_t)(l * 3 + (s == 0 ? 0 : 2)) * M};
                for (int rep = 0; rep < DUPN(1); ++rep) { if (EN(2)) pg8::gemm_phase<pg8::EpiSwiglu, pg8::StaticOrder, true, true>(glds, g, S, E); }
            } else if (s == 1 || s == 8 || s == 6) {
                const bf16* A = (s == 6) ? YB : HP; const int K = (s == 6) ? D : FF;
                const bf16* Bt = (const bf16*)(wb + (s == 1 ? WO_1D : s == 6 ? WO_OUT : WO_2D));
                unsigned long long* rsn = (s == 1) ? RS + (size_t)(l * 3 + 1) * M : (s == 6) ? RS + (size_t)(l * 3 + 2) * M : (l + 1 < NLAYER) ? RS + (size_t)((l + 1) * 3) * M : nullptr;
                float* outf = (s == 8 && l + 1 == NLAYER) ? X : nullptr;
                pg8::Gemm g{A, Bt, M, D, K}; pg8::StaticOrder S; S.init(M, D, C.nblk, C.blk);
                pg8::EpiResid E{XN, outf, D, (s == 6) ? 1.0f : 0.5f, rsn};
                if (EN(3)) pg8::gemm_phase<pg8::EpiResid, pg8::StaticOrder, true, true>(glds, g, S, E);
            } else if (s == 2) {
                pg8::Gemm g{XN, (const bf16*)(wb + WO_IN), M, NPG, D}; pg8::StaticOrder S; S.init(M, NPG, C.nblk, C.blk);
                pg8::EpiRowScale E{HP, NP, RS + (size_t)(l * 3 + 1) * M};
                for (int rep = 0; rep < DUPN(2); ++rep) { if (EN(4)) pg8::gemm_phase<pg8::EpiRowScale, pg8::StaticOrder, true, true>(glds, g, S, E); }
                for (int u = C.blk * 8 + C.wave; u < M / 16; u += C.nblk * 8) small_gates_unit(C, XN, (const bf16*)(wb + WO_IN), RS + (size_t)(l * 3 + 1) * M, HP, u);
            } else if (s == 3) {
                const int vblk = (C.nblk % 8 == 0) ? (C.blk % 8) * (C.nblk / 8) + C.blk / 8 : C.blk;
                for (int u = vblk; u < 1024; u += C.nblk) {
                    if (u < 512) { if (EN(5)) REPT(5) gla_passA(C, HP, GST, GD, in_ptr(a, 7) + l * 16 * 256, in_ptr(a, 8) + l * 256, u); }
                    else if (EN(6)) REPT(6) ssd_passA(C, HP, XS, SST, SD, in_ptr(a, 14) + l * 4 * 768, in_ptr(a, 15) + l * 768, in_ptr(a, 16) + l * 4, in_ptr(a, 17) + l * 4, u - 512);
                }
                const int gw = C.blk * 8 + C.wave, NGW = C.nblk * 8;
                for (int u = gw; u < 2048; u += NGW) {
                    if (u < 1024) { if (EN(7)) REPT(7) sc_unit(C, HP, YB, in_ptr(a, 20) + l * 3 * 256, in_ptr(a, 21) + l * 256, u); }
                    else if (EN(8)) foxprep_unit(C, HP, VT, FRAW, in_ptr(a, 10) + l * 4, u - 1024);
                }
            } else if (s == 4) {
                if (EN(9)) scan_phase(C, GST, GD, GSB, SST, SD, SSB, FRAW, FL);
            } else {
                const int vblk = (C.nblk % 8 == 0) ? (C.blk % 8) * (C.nblk / 8) + C.blk / 8 : C.blk;
                const int nun = (1536 + C.nblk - 1 - vblk) / C.nblk, rot = (C.blk & 1) ? ((nun >= 3) ? nun / 3 : 0) : 0;
                for (int k_ = 0; k_ < nun; ++k_) { const int u = vblk + ((k_ + rot) % nun) * C.nblk;
                    if (u < 512) { if (EN(10)) REPT(10) fox_attn_unit(C, HP, VT, FL, YB, in_ptr(a, 11) + l * 64, in_ptr(a, 12) + l * 64, in_ptr(a, 13) + l * 256, u); }
                    else if (u < 1024) { if (EN(11)) REPT(11) ssd_passC(C, HP, XS, SSB, YB, in_ptr(a, 14) + l * 4 * 768, in_ptr(a, 15) + l * 768, in_ptr(a, 16) + l * 4, in_ptr(a, 17) + l * 4, in_ptr(a, 18) + l * 4, in_ptr(a, 19) + l * 256, u - 512); }
                    else if (EN(12)) REPT(12) gla_passC(C, HP, GSB, YB, in_ptr(a, 7) + l * 16 * 256, in_ptr(a, 8) + l * 256, in_ptr(a, 9) + l * 256, u - 1024);
                }
            }
        }
        if (ph + 1 < a.ph_hi) { xcd_barrier_flatrel(bar, nbar); if (DUPN(5) == 2) xcd_barrier_flatrel(bar, nbar); }
    }
}

extern "C" void kernel_launch(void* const* d_in, const int* in_sizes, int n_in, void* d_out, int out_size, void* d_ws, size_t ws_size, hipStream_t stream) {
    static int grid = 0;
    if (grid == 0) {
        if (n_in != 27 || out_size != M * D || ws_size < WS_END) { fprintf(stderr, "kernel_launch: unexpected shapes (n_in %d out %d ws %zu)\n", n_in, out_size, ws_size); grid = -1; return; }
        int dev = 0, cus = 0, per_cu = 0;
        (void)hipGetDevice(&dev); (void)hipDeviceGetAttribute(&cus, hipDeviceAttributeMultiprocessorCount, dev);
        (void)hipFuncSetAttribute((const void*)mega, hipFuncAttributeMaxDynamicSharedMemorySize, LDS_BYTES);
        (void)hipOccupancyMaxActiveBlocksPerMultiprocessor(&per_cu, (const void*)mega, NTHREADS, LDS_BYTES);
        if (per_cu < 1) per_cu = 1;
        (void)hipGetLastError();
        grid = cus * per_cu;
    }
    if (grid < 0) return;
    Args a{};
    for (int i = 0; i < 27; ++i) a.in[i] = (const float*)d_in[i];
    a.out = (float*)d_out; a.ws = (unsigned char*)d_ws;
#if MK_PER_PHASE
    for (int ph = 0; ph < NPHASE; ++ph) { a.ph_lo = ph; a.ph_hi = ph + 1; hipLaunchKernelGGL(mega, dim3(grid), dim3(NTHREADS), LDS_BYTES, stream, a); }
#else
    a.ph_lo = 0; a.ph_hi = NPHASE;
    (void)hipMemsetAsync(d_ws, 0, 16384, stream);
    void* args[] = {&a};
    hipError_t e = hipLaunchCooperativeKernel((const void*)mega, dim3(grid), dim3(NTHREADS), args, LDS_BYTES, stream);
    if (e != hipSuccess) fprintf(stderr, "cooperative launch failed: %s (grid %d)\n", hipGetErrorString(e), grid);
#endif
}
```

```cpp
#include <hip/hip_runtime.h>
#include <hip/hip_cooperative_groups.h>
#include <cstdio>
#include <cstdint>
namespace cg = cooperative_groups;
namespace pg8 {
#define PG8_LAS __attribute__((address_space(3)))
typedef unsigned short bf16_t;
typedef short bf16x8 __attribute__((ext_vector_type(8)));
typedef float f32x4 __attribute__((ext_vector_type(4)));
typedef unsigned u32x4 __attribute__((ext_vector_type(4)));
constexpr int BM = 256, BK = 64, HALF = 128, HTB = HALF * BK * 2  , STAGE_BYTES = 8 * HTB, NXCD = 8, WGM = 8;

__host__ __device__ __forceinline__ int lds_byte(int r, int c) { const int st = (r >> 4) * 2 + (c >> 5), rr = r & 15, cc = c & 31, ob = rr * 64 + cc * 2; return st * 1024 + (ob ^ (((ob >> 9) & 1) << 5)); }
__host__ __device__ __forceinline__ void stage_rc(int b, int& R, int& C) { const int st = b / 1024, sb = b % 1024, swz = sb ^ (((sb >> 9) & 1) << 5); R = (st >> 1) * 16 + swz / 64; C = (st & 1) * 32 + (swz % 64) / 2; }
__host__ __device__ __forceinline__ int perm32(int rho) { const int n = rho >> 4, i = rho & 15; return 8 * (i >> 2) + 4 * n + (i & 3); }

struct Unit { int pm, pn; };
struct Gemm { const bf16_t* A; const bf16_t* Bt; int M, N, K; };

struct StaticOrder {
    int nM, nN, nwg, G, c;
    __host__ __device__ void init(int M, int N, int G_, int c_) { nM = M / BM; nN = N / BM; nwg = nM * nN; G = G_; c = c_; }
    __host__ __device__ bool next(int i, Unit& u) const {
        const long L = (long)i * G + c; if (L >= nwg) return false;
        int wgid = (int)L; { const int q = nwg / NXCD, r = nwg % NXCD, xcd = wgid % NXCD, off = wgid / NXCD; wgid = (xcd < r ? xcd * (q + 1) : r * (q + 1) + (xcd - r) * q) + off; }
        const int nig = WGM * nN, gid = wgid / nig, fm = gid * WGM, gsz = (nM - fm) < WGM ? (nM - fm) : WGM;
        u.pm = fm + ((wgid % nig) % gsz); u.pn = (wgid % nig) / gsz; return true;
    }
    __device__ __forceinline__ void a_ready(const Unit&) const {}
    __device__ __forceinline__ void done(const Unit&) const {}
};

__device__ __forceinline__ unsigned cvt_pk_bf16(float lo, float hi) { unsigned r; asm volatile("v_cvt_pk_bf16_f32 %0, %1, %2" : "=v"(r) : "v"(lo), "v"(hi)); return r; }
typedef float f32x2 __attribute__((ext_vector_type(2)));
__device__ __forceinline__ f32x2 gelu_pk(f32x2 v) {
    const f32x2 av = __builtin_elementwise_abs(v), d = av * 0.2316418882f + 1.0f;
    f32x2 t; t.x = __builtin_amdgcn_rcpf(d.x); t.y = __builtin_amdgcn_rcpf(d.y);
    f32x2 q = t * 0.5307027145f + (-0.7265760135f); q = q * t + 0.7107068705f; q = q * t + (-0.142248368f); q = q * t + 0.127414796f; q = q * t;
    const f32x2 s = (v * v) * (-0.72134752044f);
    f32x2 e; e.x = __builtin_amdgcn_exp2f(s.x); e.y = __builtin_amdgcn_exp2f(s.y);
    const f32x2 m = v * (q * e), r = v - m;
    f32x2 o; o.x = v.x < 0.f ? m.x : r.x; o.y = v.y < 0.f ? m.y : r.y; return o;
}

template <int ACT  > struct EpiBf16 {
    static constexpr bool PERM = true, AFTER_DRAIN = false; static_assert(ACT == 0 || ACT == 1, "EpiBf16: ACT is 0 (none) or 1 (gelu_pk)");
    bf16_t* O; int ldc; const float* bias; int split_cols; size_t split_stride; float scale0;
    __device__ __forceinline__ void pre(const Unit&, int, int, float (&)[8]) const {}
    __device__ __forceinline__ void operator()(const f32x4 (&acc)[2][2][4][2], const Unit& u, int wr, int wc, int fr, int fq, const float (&)[8]) const {
        const int row0 = u.pm * BM + wr * 64 + fr; int colt = u.pn * BM; bf16_t* base = O;
        float sc = 1.f; if (split_cols) { const int t = colt / split_cols; base += (size_t)t * split_stride; colt -= t * split_cols; if (t == 0) sc = scale0; }
        const int col0 = colt + wc * 32 + 8 * fq, bcol0 = u.pn * BM + wc * 32 + 8 * fq;
        f32x4 bv[2][2];
#pragma unroll
        for (int bj = 0; bj < 2; ++bj)
#pragma unroll
            for (int n = 0; n < 2; ++n) bv[bj][n] = bias ? *(const f32x4*)(bias + bcol0 + bj * HALF + 4 * n) : (f32x4){0.f, 0.f, 0.f, 0.f};
#pragma unroll
        for (int ai = 0; ai < 2; ++ai)
#pragma unroll
            for (int m = 0; m < 4; ++m) { bf16_t* rowp = base + (size_t)(row0 + ai * HALF + m * 16) * ldc + col0;
#pragma unroll
                for (int bj = 0; bj < 2; ++bj) { f32x4 v0 = acc[ai][bj][m][0] + bv[bj][0], v1 = acc[ai][bj][m][1] + bv[bj][1];
                    if (ACT == 1) { f32x2 a = gelu_pk((f32x2){v0[0], v0[1]}), b = gelu_pk((f32x2){v0[2], v0[3]}), c = gelu_pk((f32x2){v1[0], v1[1]}), d = gelu_pk((f32x2){v1[2], v1[3]});
                        v0 = (f32x4){a.x, a.y, b.x, b.y}; v1 = (f32x4){c.x, c.y, d.x, d.y}; }
                    v0 = v0 * sc; v1 = v1 * sc; u32x4 w; w.x = cvt_pk_bf16(v0[0], v0[1]); w.y = cvt_pk_bf16(v0[2], v0[3]); w.z = cvt_pk_bf16(v1[0], v1[1]); w.w = cvt_pk_bf16(v1[2], v1[3]);
                    *(u32x4*)(rowp + bj * HALF) = w; } }
    }
};
__device__ __forceinline__ float silu_f(float x) { return x * __builtin_amdgcn_rcpf(1.0f + __builtin_amdgcn_exp2f(-1.4426950408889634f * x)); }
struct EpiSwiglu {
    static constexpr bool PERM = true, AFTER_DRAIN = false;
    bf16_t* O; int ldc; const unsigned long long* rs;
    __device__ __forceinline__ void pre(const Unit& u, int wr, int fr, float (&epf)[8]) const {
#pragma unroll
        for (int k = 0; k < 8; ++k) epf[k] = (float)rs[u.pm * BM + wr * 64 + fr + (k >> 2) * HALF + (k & 3) * 16] * (1.0f / 1048576.0f);
    }
    __device__ __forceinline__ void operator()(const f32x4 (&acc)[2][2][4][2], const Unit& u, int wr, int wc, int fr, int fq, const float (&epf)[8]) const {
        const int row0 = u.pm * BM + wr * 64 + fr; const int col0 = u.pn * HALF + wc * 32 + 8 * fq;
#pragma unroll
        for (int ai = 0; ai < 2; ++ai)
#pragma unroll
            for (int m = 0; m < 4; ++m) { const int row = row0 + ai * HALF + m * 16; bf16_t* rowp = O + (size_t)row * ldc + col0;
                const float r = rsqrtf(epf[ai * 4 + m] * (1.0f / 1024.0f) + 1e-6f);
                const f32x4 g0 = acc[ai][0][m][0] * r, g1 = acc[ai][0][m][1] * r, u0 = acc[ai][1][m][0] * r, u1 = acc[ai][1][m][1] * r;
                u32x4 w; w.x = cvt_pk_bf16(silu_f(g0[0]) * u0[0], silu_f(g0[1]) * u0[1]); w.y = cvt_pk_bf16(silu_f(g0[2]) * u0[2], silu_f(g0[3]) * u0[3]);
                w.z = cvt_pk_bf16(silu_f(g1[0]) * u1[0], silu_f(g1[1]) * u1[1]); w.w = cvt_pk_bf16(silu_f(g1[2]) * u1[2], silu_f(g1[3]) * u1[3]);
                *(u32x4*)rowp = w; }
    }
};
struct EpiRowScale {
    static constexpr bool PERM = true, AFTER_DRAIN = false;
    bf16_t* O; int ldc; const unsigned long long* rs;
    __device__ __forceinline__ void pre(const Unit& u, int wr, int fr, float (&epf)[8]) const {
#pragma unroll
        for (int k = 0; k < 8; ++k) epf[k] = (float)rs[u.pm * BM + wr * 64 + fr + (k >> 2) * HALF + (k & 3) * 16] * (1.0f / 1048576.0f);
    }
    __device__ __forceinline__ void operator()(const f32x4 (&acc)[2][2][4][2], const Unit& u, int wr, int wc, int fr, int fq, const float (&epf)[8]) const {
        const int row0 = u.pm * BM + wr * 64 + fr; const int col0 = u.pn * BM + wc * 32 + 8 * fq;
#pragma unroll
        for (int ai = 0; ai < 2; ++ai)
#pragma unroll
            for (int m = 0; m < 4; ++m) { const int row = row0 + ai * HALF + m * 16; bf16_t* rowp = O + (size_t)row * ldc + col0;
                const float r = rsqrtf(epf[ai * 4 + m] * (1.0f / 1024.0f) + 1e-6f);
#pragma unroll
                for (int bj = 0; bj < 2; ++bj) { const f32x4 v0 = acc[ai][bj][m][0] * r, v1 = acc[ai][bj][m][1] * r;
                    u32x4 w; w.x = cvt_pk_bf16(v0[0], v0[1]); w.y = cvt_pk_bf16(v0[2], v0[3]); w.z = cvt_pk_bf16(v1[0], v1[1]); w.w = cvt_pk_bf16(v1[2], v1[3]);
                    *(u32x4*)(rowp + bj * HALF) = w; } }
    }
};
struct EpiResid {
    static constexpr bool PERM = false, AFTER_DRAIN = false;
    bf16_t* xb; float* outf; int ldc; float scale; unsigned long long* rsn;
    __device__ __forceinline__ void pre(const Unit&, int, int, float (&)[8]) const {}
    __device__ __forceinline__ void operator()(const f32x4 (&acc)[2][2][4][2], const Unit& u, int wr, int wc, int fr, int fq, const float (&)[8]) const {
        const int row0 = u.pm * BM + wr * 64 + fr; const int col0 = u.pn * BM + wc * 32 + 4 * fq;
        typedef unsigned u32x2v __attribute__((ext_vector_type(2)));
#pragma unroll
        for (int ai = 0; ai < 2; ++ai)
#pragma unroll
            for (int m = 0; m < 4; ++m) { const int row = row0 + ai * HALF + m * 16; const size_t off = (size_t)row * ldc + col0; float ss = 0.f;
                u32x2v bs[2][2];
#pragma unroll
                for (int bj = 0; bj < 2; ++bj)
#pragma unroll
                    for (int n = 0; n < 2; ++n) bs[bj][n] = *(const u32x2v*)(xb + off + bj * HALF + n * 16);
#pragma unroll
                for (int bj = 0; bj < 2; ++bj)
#pragma unroll
                    for (int n = 0; n < 2; ++n) { const f32x4 b4 = (f32x4){__uint_as_float(bs[bj][n].x << 16), __uint_as_float(bs[bj][n].x & 0xffff0000u), __uint_as_float(bs[bj][n].y << 16), __uint_as_float(bs[bj][n].y & 0xffff0000u)};
                        const f32x4 v = b4 + acc[ai][bj][m][n] * scale;
                        if (outf) { *(f32x4*)(outf + off + bj * HALF + n * 16) = v; }
                        else { u32x2v w; w.x = cvt_pk_bf16(v[0], v[1]); w.y = cvt_pk_bf16(v[2], v[3]); *(u32x2v*)(xb + off + bj * HALF + n * 16) = w;
                            const float r0 = __uint_as_float(w.x << 16), r1 = __uint_as_float(w.x & 0xffff0000u), r2 = __uint_as_float(w.y << 16), r3 = __uint_as_float(w.y & 0xffff0000u);
                            ss += (r0 * r0 + r1 * r1) + (r2 * r2 + r3 * r3); } }
                if (rsn) { ss += __shfl_xor(ss, 16); ss += __shfl_xor(ss, 32); if (fq == 0) atomicAdd(rsn + row, (unsigned long long)(ss * 1048576.0f + 0.5f)); } }
    }
};
template <class Epi, class Sched, bool ALIGN_EPI = false, bool SP2 = false>
__device__ __forceinline__ void gemm_phase(PG8_LAS unsigned char* lds, const Gemm g, const Sched& S, const Epi& E) {
    int tid_l = threadIdx.x; asm volatile("" : "+v"(tid_l));
    const int tid = tid_l, wid = __builtin_amdgcn_readfirstlane(tid >> 6), lane = tid & 63, wr = wid >> 2, wc = wid & 3, fr = lane & 15, fq = lane >> 4;
    const int K = g.K, nt = K / BK;
    unsigned voffA[2], voffB[2];
#pragma unroll
    for (int i = 0; i < 2; ++i) { int R, C; stage_rc(tid * 16 + i * 8192, R, C); const int Rb = Epi::PERM ? ((R & ~31) + perm32(R & 31)) : R;
        voffA[i] = (unsigned)(R * K + C) * 2u; voffB[i] = (unsigned)(Rb * K + C) * 2u; }
    const size_t kstep = (size_t)(BK * 2);
    const size_t hstep = (size_t)HALF * K * 2;
    const size_t tstep = 2 * hstep;
    const unsigned ldsw = (unsigned)wid * 1024u;
    const int aoff = lds_byte(wr * 64 + fr, fq * 8), boff = lds_byte(wc * 32 + fr, fq * 8);
#define PG8_SA(b, h) (((b) * 2 + (h)) * HTB)
#define PG8_SB(b, h) ((4 + (b) * 2 + (h)) * HTB)
#define PG8_STAGE(bufoff, gbase, voff) do { _Pragma("unroll") for (int _i = 0; _i < 2; ++_i) \
        __builtin_amdgcn_global_load_lds((const unsigned*)((const char*)(gbase) + (voff)[_i]), (PG8_LAS unsigned*)(lds + (bufoff) + ldsw + _i * 8192), 16, 0, 0); } while (0)
#define PG8_LDA(dst, b, h) do { _Pragma("unroll") for (int m = 0; m < 4; ++m) _Pragma("unroll") for (int k = 0; k < 2; ++k) dst[m][k] = *(const PG8_LAS bf16x8*)(lds + PG8_SA(b, h) + aoff + m * 2048 + k * 1024); } while (0)
#define PG8_LDB(dst, b, h) do { _Pragma("unroll") for (int n = 0; n < 2; ++n) _Pragma("unroll") for (int k = 0; k < 2; ++k) dst[n][k] = *(const PG8_LAS bf16x8*)(lds + PG8_SB(b, h) + boff + n * 2048 + k * 1024); } while (0)
#define PG8_MMA(ai, bj, At, Bt) do { __builtin_amdgcn_s_setprio(1); _Pragma("unroll") for (int m = 0; m < 4; ++m) _Pragma("unroll") for (int n = 0; n < 2; ++n) _Pragma("unroll") for (int k = 0; k < 2; ++k) \
        acc[ai][bj][m][n] = __builtin_amdgcn_mfma_f32_16x16x32_bf16(Bt[n][k], At[m][k], acc[ai][bj][m][n], 0, 0, 0); __builtin_amdgcn_s_setprio(0); } while (0)
#define PG8_WAIT_V(n) asm volatile("s_waitcnt vmcnt(" #n ")" ::: "memory")
#define PG8_WAIT_L(n) asm volatile("s_waitcnt lgkmcnt(" #n ")" ::: "memory")
#define PG8_BAR __builtin_amdgcn_s_barrier()
#define PG8_SCHED __builtin_amdgcn_sched_barrier(0)
    Unit cur, nxt; int ui = 0;
    if (!S.next(0, cur)) return;
    float epf[8]; E.pre(cur, wr, fr, epf);
    f32x4 acc[2][2][4][2];
#pragma unroll
    for (int a = 0; a < 2; ++a)
#pragma unroll
        for (int b = 0; b < 2; ++b)
#pragma unroll
            for (int m = 0; m < 4; ++m)
#pragma unroll
                for (int n = 0; n < 2; ++n) acc[a][b][m][n] = (f32x4){0.f, 0.f, 0.f, 0.f};
    bf16x8 At[4][2], B0[2][2], B1[2][2];
    const char* cA = (const char*)g.A + (size_t)cur.pm * tstep; const char* cB = (const char*)g.Bt + (size_t)cur.pn * tstep;
    S.a_ready(cur);
    if constexpr (SP2) {
        PG8_STAGE(PG8_SB(0, 0), cB, voffB); PG8_STAGE(PG8_SB(0, 1), cB + hstep, voffB); PG8_STAGE(PG8_SA(0, 0), cA, voffA); PG8_STAGE(PG8_SA(0, 1), cA + hstep, voffA);
        if (wr == 1) PG8_BAR;
        PG8_WAIT_V(2); PG8_BAR;
        PG8_STAGE(PG8_SB(1, 0), cB + kstep, voffB); PG8_STAGE(PG8_SA(1, 0), cA + kstep, voffA); PG8_STAGE(PG8_SB(1, 1), cB + hstep + kstep, voffB);
        PG8_WAIT_V(6); PG8_BAR;
    } else {
        PG8_STAGE(PG8_SB(0, 0), cB, voffB); PG8_STAGE(PG8_SA(0, 0), cA, voffA); PG8_STAGE(PG8_SB(0, 1), cB + hstep, voffB); PG8_STAGE(PG8_SA(0, 1), cA + hstep, voffA);
        if (wr == 1) PG8_BAR;
        PG8_WAIT_V(4); PG8_BAR;
        PG8_STAGE(PG8_SB(1, 0), cB + kstep, voffB); PG8_STAGE(PG8_SA(1, 0), cA + kstep, voffA); PG8_STAGE(PG8_SB(1, 1), cB + hstep + kstep, voffB);
        PG8_WAIT_V(6); PG8_BAR;
    }
    for (;;) {
        const bool has_next = S.next(ui + 1, nxt);
        const char* nA = has_next ? (const char*)g.A + (size_t)nxt.pm * tstep : cA; const char* nB = has_next ? (const char*)g.Bt + (size_t)nxt.pn * tstep : cB;
        for (int t = 0; t < nt; t += 2) {
            const bool last = (t == nt - 2);
            const char* a1 = cA + (size_t)(t + 1) * kstep;
            const char* a2 = last ? nA : cA + (size_t)(t + 2) * kstep; const char* b2 = last ? nB : cB + (size_t)(t + 2) * kstep;
            const char* a3 = a2 + kstep; const char* b3 = b2 + kstep;
            if (last && has_next) S.a_ready(nxt);
            if constexpr (SP2) {
            PG8_LDB(B0, 0, 0); PG8_LDB(B1, 0, 1); PG8_SCHED; PG8_LDA(At, 0, 0); PG8_STAGE(PG8_SA(1, 1), a1 + hstep, voffA);
            PG8_WAIT_V(8); PG8_WAIT_L(0); PG8_BAR; PG8_MMA(0, 0, At, B0); PG8_MMA(0, 1, At, B1); PG8_BAR; PG8_SCHED;
            PG8_LDA(At, 0, 1); PG8_STAGE(PG8_SB(0, 0), b2, voffB); PG8_STAGE(PG8_SB(0, 1), b2 + hstep, voffB); PG8_STAGE(PG8_SA(0, 0), a2, voffA);
            PG8_WAIT_V(8); PG8_WAIT_L(0); PG8_BAR; PG8_MMA(1, 0, At, B0); PG8_MMA(1, 1, At, B1); PG8_BAR; PG8_SCHED;
            PG8_LDB(B0, 1, 0); PG8_LDB(B1, 1, 1); PG8_SCHED; PG8_LDA(At, 1, 0); PG8_STAGE(PG8_SA(0, 1), a2 + hstep, voffA);
            PG8_WAIT_V(8); PG8_WAIT_L(0); PG8_BAR; PG8_MMA(0, 0, At, B0); PG8_MMA(0, 1, At, B1); PG8_BAR; PG8_SCHED;
            PG8_LDA(At, 1, 1); PG8_STAGE(PG8_SB(1, 0), b3, voffB); PG8_STAGE(PG8_SB(1, 1), b3 + hstep, voffB); PG8_STAGE(PG8_SA(1, 0), a3, voffA);
            PG8_WAIT_V(8); PG8_WAIT_L(0); PG8_BAR; PG8_MMA(1, 0, At, B0); PG8_MMA(1, 1, At, B1); PG8_BAR; PG8_SCHED;
            } else {
            PG8_LDB(B0, 0, 0); PG8_SCHED; PG8_LDA(At, 0, 0); PG8_STAGE(PG8_SA(1, 1), a1 + hstep, voffA);
            PG8_WAIT_L(8); PG8_BAR; PG8_WAIT_L(0); PG8_MMA(0, 0, At, B0); PG8_BAR; PG8_SCHED;
            PG8_LDB(B1, 0, 1); PG8_STAGE(PG8_SB(0, 0), b2, voffB);
            PG8_BAR; PG8_WAIT_L(0); PG8_MMA(0, 1, At, B1); PG8_BAR;
            PG8_LDA(At, 0, 1); PG8_STAGE(PG8_SA(0, 0), a2, voffA);
            PG8_BAR; PG8_WAIT_L(0); PG8_MMA(1, 0, At, B0); PG8_BAR; PG8_SCHED;
            PG8_STAGE(PG8_SB(0, 1), b2 + hstep, voffB);
            PG8_WAIT_V(6); PG8_BAR; PG8_MMA(1, 1, At, B1); PG8_BAR;
            PG8_LDB(B0, 1, 0); PG8_SCHED; PG8_LDA(At, 1, 0); PG8_STAGE(PG8_SA(0, 1), a2 + hstep, voffA);
            PG8_WAIT_L(8); PG8_BAR; PG8_WAIT_L(0); PG8_MMA(0, 0, At, B0); PG8_BAR; PG8_SCHED;
            PG8_LDB(B1, 1, 1); PG8_STAGE(PG8_SB(1, 0), b3, voffB);
            PG8_BAR; PG8_WAIT_L(0); PG8_MMA(0, 1, At, B1); PG8_BAR;
            PG8_LDA(At, 1, 1); PG8_STAGE(PG8_SA(1, 0), a3, voffA);
            PG8_BAR; PG8_WAIT_L(0); PG8_MMA(1, 0, At, B0); PG8_BAR; PG8_SCHED;
            PG8_STAGE(PG8_SB(1, 1), b3 + hstep, voffB);
            PG8_WAIT_V(6); PG8_BAR; PG8_MMA(1, 1, At, B1); PG8_BAR;
            }
        }
        if constexpr (ALIGN_EPI) { if (wr == 0) PG8_BAR; }
        if constexpr (!Epi::AFTER_DRAIN) { E(acc, cur, wr, wc, fr, fq, epf); S.done(cur); }
        if (!has_next) break;
#pragma unroll
        for (int a = 0; a < 2; ++a)
#pragma unroll
            for (int b = 0; b < 2; ++b)
#pragma unroll
                for (int m = 0; m < 4; ++m)
#pragma unroll
                    for (int n = 0; n < 2; ++n) acc[a][b][m][n] = (f32x4){0.f, 0.f, 0.f, 0.f};
        cur = nxt; cA = nA; cB = nB; ++ui;
        E.pre(cur, wr, fr, epf);
        if constexpr (ALIGN_EPI) { if (wr == 1) PG8_BAR; }
    }
    PG8_WAIT_V(0);
    if constexpr (!ALIGN_EPI) { if (wr == 0) PG8_BAR; }
    PG8_BAR;
    if constexpr (Epi::AFTER_DRAIN) { E.fused(acc, cur, wr, wc, fr, fq, lds, wid, lane); S.done(cur); }
#undef PG8_SA
#undef PG8_SB
#undef PG8_STAGE
#undef PG8_LDA
#undef PG8_LDB
#undef PG8_MMA
#undef PG8_WAIT_V
#undef PG8_WAIT_L
#undef PG8_BAR
#undef PG8_SCHED
}
}

#define LAS __attribute__((address_space(3)))
typedef LAS unsigned char* ldsp;
typedef unsigned short bf16;
typedef short bf16x8 __attribute__((ext_vector_type(8)));
typedef float f32x4 __attribute__((ext_vector_type(4)));
typedef float f32x16 __attribute__((ext_vector_type(16)));
typedef unsigned u32x4 __attribute__((ext_vector_type(4)));
typedef unsigned u32x2 __attribute__((ext_vector_type(2)));
typedef float f32x2_t __attribute__((ext_vector_type(2)));
typedef __bf16 bf16x2_t __attribute__((ext_vector_type(2)));

constexpr int NBATCH = 4, L = 8192, M = NBATCH * L, D = 1024, FF = 2816, NUP = 2 * FF, NP = 3840, NPG = 3584, NLAYER = 2;
constexpr float EPS = 1e-6f, LOG2E = 1.4426950408889634f;
constexpr int PC_AQ = 0, PC_AK = 256, PC_AV = 512, PC_AG = 768, PC_BQ = 1024, PC_BK = 1280, PC_BV = 1536, PC_CZ = 1792, PC_XBC = 2048,
              PC_DB = 2816, PC_DC = 3072, PC_DV = 3328, PC_ALR = 3584, PC_BF = 3600, PC_DT = 3604;
constexpr size_t MiB = 1u << 20;
constexpr size_t WS_W = 1 * MiB, W_LSTRIDE = 42 * MiB + 512 * 1024;
constexpr size_t WO_1U = 0, WO_1D = 11 * MiB, WO_IN = 16 * MiB + 512 * 1024, WO_OUT = 24 * MiB, WO_2U = 26 * MiB, WO_2D = 37 * MiB;
constexpr size_t WS_RS = 489 * MiB;
constexpr size_t WS_XN = 86 * MiB;
constexpr size_t WS_HP = 150 * MiB;
constexpr size_t WS_XG2 = WS_HP + 176 * MiB;
constexpr size_t WS_VT = 390 * MiB;
constexpr size_t WS_GST = 406 * MiB;
constexpr size_t WS_GD = 438 * MiB;
constexpr size_t WS_SST = 439 * MiB;
constexpr size_t WS_SD = 471 * MiB;
constexpr size_t WS_FRAW = 471 * MiB + 65536;
constexpr size_t WS_FL = 472 * MiB;
constexpr size_t WS_XS = 473 * MiB;
constexpr size_t WS_END = 491 * MiB;
constexpr int LDS_BYTES = 150 * 1024;
constexpr int NTHREADS = 512;

template <class T> __device__ __forceinline__ T lds_ld(ldsp p, int off) { return *(const LAS T*)(p + off); }
template <class T> __device__ __forceinline__ void lds_st(ldsp p, int off, T v) { *(LAS T*)(p + off) = v; }
__device__ __forceinline__ ldsp lds_opaque(ldsp p) { unsigned a = (unsigned)(size_t)p; asm volatile("" : "+v"(a)); return (ldsp)(size_t)a; }
__device__ __forceinline__ float bf2f(bf16 u) { return __uint_as_float((unsigned)u << 16); }
__device__ __forceinline__ unsigned pk2(float lo, float hi) { f32x2_t v = {lo, hi}; bf16x2_t b = __builtin_convertvector(v, bf16x2_t); return __builtin_bit_cast(unsigned, b); }
__device__ __forceinline__ bf16 f2bf(float f) { return (bf16)(pk2(f, 0.f) & 0xffffu); }
__device__ __forceinline__ float lo16(unsigned w) { return __uint_as_float(w << 16); }
__device__ __forceinline__ float hi16(unsigned w) { return __uint_as_float(w & 0xffff0000u); }
__device__ __forceinline__ bf16x8 pack8(float a0, float a1, float a2, float a3, float a4, float a5, float a6, float a7) {
    u32x4 w; w.x = pk2(a0, a1); w.y = pk2(a2, a3); w.z = pk2(a4, a5); w.w = pk2(a6, a7); return __builtin_bit_cast(bf16x8, w); }
__device__ __forceinline__ bf16x8 cat2(u32x2 a, u32x2 b) { u32x4 w; w.x = a.x; w.y = a.y; w.z = b.x; w.w = b.y; return __builtin_bit_cast(bf16x8, w); }
__device__ __forceinline__ float silu(float x) { return x / (1.0f + __expf(-x)); }
__device__ __forceinline__ float logsigmoid(float x) { return fminf(x, 0.f) - log1pf(__expf(-fabsf(x))); }
__device__ __forceinline__ float softplus(float x) { return fmaxf(x, 0.f) + log1pf(__expf(-fabsf(x))); }
__device__ __forceinline__ int crow(int r, int hi) { return (r & 3) + 8 * (r >> 2) + 4 * hi; }
#define MFMA32(a, b, c) __builtin_amdgcn_mfma_f32_32x32x16_bf16((a), (b), (c), 0, 0, 0)
__device__ __forceinline__ void unpack8(u32x4 w, float (&o)[8]) { o[0] = lo16(w.x); o[1] = hi16(w.x); o[2] = lo16(w.y); o[3] = hi16(w.y); o[4] = lo16(w.z); o[5] = hi16(w.z); o[6] = lo16(w.w); o[7] = hi16(w.w); }

struct Ctx {
    unsigned char* ws;
    ldsp lds; int tid, lane, wave, nblk, blk;
};

__device__ __forceinline__ Ctx relaunder(const Ctx& C0) { Ctx C = C0; int t = C0.tid; asm volatile("" : "+v"(t)); C.tid = t; C.lane = t & 63; C.wave = __builtin_amdgcn_readfirstlane(t >> 6); return C; }

__device__ __forceinline__ int win_src_col(int j) {
    if (j < 1024) return j;
    if (j < 1792) return j + 16;
    if (j < 2816) return j + 20;
    if (j < 3584) return j + 24;
    if (j < 3600) return 1024 + (j - 3584);
    if (j < 3604) return 1808 + (j - 3600);
    if (j < 3608) return 2836 + (j - 3604);
    return -1;
}
__device__ __forceinline__ void wt_item(int kind, const float* W0, const float* W1, const float* gsc, int K, int Nsrc, int Ndst, bf16* WT, ldsp scr, int item, int lane) {
    const int nblk = Ndst / 32, kb = item / nblk, nb = item % nblk, k0 = 64 * kb, n0 = 32 * nb;
    const int nd = n0 + (lane & 31);
    const float* src = W0; int col = nd;
    if (kind == 1) { const int pn = nd >> 8, bj = (nd >> 7) & 1, cc = nd & 127; src = bj ? W1 : W0; col = pn * 128 + cc; }
    else if (kind == 2) { col = win_src_col(nd); }
    float vv[32];
#pragma unroll
    for (int i = 0; i < 32; ++i) { const int kk = 2 * i + (lane >> 5); vv[i] = (col >= 0) ? src[(size_t)(k0 + kk) * Nsrc + col] : 0.f; }
    float gs = 1.f; const float* gp = gsc ? gsc + k0 + (lane >> 5) : nullptr;
#pragma unroll
    for (int i = 0; i < 32; ++i) { const int kk = 2 * i + (lane >> 5); if (gp) gs = gp[2 * i]; lds_st<float>(scr, (kk * 33 + (lane & 31)) * 4, vv[i] * gs); }
    asm volatile("s_waitcnt lgkmcnt(0)" ::: "memory");
    const int c = lane & 7;
#pragma unroll
    for (int j = 0; j < 4; ++j) { const int n = (lane >> 3) + 8 * j; const int so = ((8 * c) * 33 + n) * 4;
        u32x4 o; o.x = pk2(lds_ld<float>(scr, so), lds_ld<float>(scr, so + 33 * 4)); o.y = pk2(lds_ld<float>(scr, so + 2 * 33 * 4), lds_ld<float>(scr, so + 3 * 33 * 4));
        o.z = pk2(lds_ld<float>(scr, so + 4 * 33 * 4), lds_ld<float>(scr, so + 5 * 33 * 4)); o.w = pk2(lds_ld<float>(scr, so + 6 * 33 * 4), lds_ld<float>(scr, so + 7 * 33 * 4));
        *(u32x4*)(WT + (size_t)(n0 + n) * K + k0 + 8 * c) = o; }
    asm volatile("s_waitcnt lgkmcnt(0)" ::: "memory");
}
struct Args { const float* in[27]; float* out; unsigned char* ws; int ph_lo, ph_hi; };
__device__ __forceinline__ const float* in_ptr(const Args& a, int k) { asm volatile("" : "+s"(k)); return a.in[k]; }
__device__ __forceinline__ void prologue(const Ctx& C, const Args& A) {
    ldsp scr = C.lds + C.wave * 8448;
    const int gw = C.blk * 8 + C.wave, NGW = C.nblk * 8;
    constexpr int I_U = 16 * (NUP / 32), I_D = (FF / 64) * 32, I_IN = 16 * (NP / 32), I_O = 16 * 32, I_L = 2 * I_U + 2 * I_D + I_IN + I_O;
    for (int it = gw; it < NLAYER * I_L; it += NGW) {
        const int l = it / I_L; int r = it % I_L;
        unsigned char* wb = C.ws + WS_W + (size_t)l * W_LSTRIDE;
        const size_t o_gu = (size_t)l * D * FF, o_dn = (size_t)l * FF * D;
        if (r < I_U) { wt_item(1, in_ptr(A, 2) + o_gu, in_ptr(A, 3) + o_gu, in_ptr(A, 1) + l * D, D, FF, NUP, (bf16*)(wb + WO_1U), scr, r, C.lane); continue; } r -= I_U;
        if (r < I_D) { wt_item(0, in_ptr(A, 4) + o_dn, nullptr, nullptr, FF, D, D, (bf16*)(wb + WO_1D), scr, r, C.lane); continue; } r -= I_D;
        if (r < I_IN) { wt_item(2, in_ptr(A, 6) + (size_t)l * D * 3608, nullptr, in_ptr(A, 5) + l * D, D, 3608, NP, (bf16*)(wb + WO_IN), scr, r, C.lane); continue; } r -= I_IN;
        if (r < I_O) { wt_item(0, in_ptr(A, 22) + (size_t)l * D * D, nullptr, nullptr, D, D, D, (bf16*)(wb + WO_OUT), scr, r, C.lane); continue; } r -= I_O;
        if (r < I_U) { wt_item(1, in_ptr(A, 24) + o_gu, in_ptr(A, 25) + o_gu, in_ptr(A, 23) + l * D, D, FF, NUP, (bf16*)(wb + WO_2U), scr, r, C.lane); continue; } r -= I_U;
        wt_item(0, in_ptr(A, 26) + o_dn, nullptr, nullptr, FF, D, D, (bf16*)(wb + WO_2D), scr, r, C.lane);
    }
}
__device__ __forceinline__ float wave_sum(float v) {
#pragma unroll
    for (int o = 1; o < 64; o <<= 1) v += __shfl_xor(v, o);
    return v;
}
__device__ __forceinline__ void norm_phase(const Ctx& C, const float* x, bf16* xb, unsigned long long* rs) {
    const int gw = C.blk * 8 + C.wave, NGW = C.nblk * 8;
    for (int m = 4 * gw; m < M; m += 4 * NGW) {
        f32x4 v[4][4];
#pragma unroll
        for (int q = 0; q < 4; ++q) { const f32x4* xr = (const f32x4*)(x + (size_t)(m + q) * D) + C.lane;
#pragma unroll
            for (int j = 0; j < 4; ++j) v[q][j] = xr[64 * j]; }
#pragma unroll
        for (int q = 0; q < 4; ++q) { u32x2* o8 = (u32x2*)(xb + (size_t)(m + q) * D) + C.lane; float s = 0.f;
#pragma unroll
            for (int j = 0; j < 4; ++j) { const f32x4 t = v[q][j]; u32x2 w; w.x = pk2(t.x, t.y); w.y = pk2(t.z, t.w); o8[64 * j] = w;
                const float r0 = lo16(w.x), r1 = hi16(w.x), r2 = lo16(w.y), r3 = hi16(w.y); s += (r0 * r0 + r1 * r1) + (r2 * r2 + r3 * r3); }
            s = wave_sum(s);
            if (C.lane == 0) rs[m + q] = (unsigned long long)(s * 1048576.0f + 0.5f); }
    }
}
#define XB_TMO      128
#define XB_XCNT(j)  (256  + 64 * (j))
#define XB_XSUB(j)  (1280 + 64 * (j))
#define XB_XGEN(j)  (2304 + 64 * (j))
#define XB_TOP      3328
#define XB_TOPGEN   3392
#define XCD_BAR_WORDS 3456
#define XB_SPIN_CAP (1u << 18)

__device__ __forceinline__ unsigned xb_ld(unsigned* p)              { return __hip_atomic_load(p, __ATOMIC_RELAXED, __HIP_MEMORY_SCOPE_AGENT); }
__device__ __forceinline__ unsigned xb_add(unsigned* p, unsigned v) { return __hip_atomic_fetch_add(p, v, __ATOMIC_RELAXED, __HIP_MEMORY_SCOPE_AGENT); }
__device__ __forceinline__ unsigned xb_xcc_id() { return (unsigned)__builtin_amdgcn_s_getreg((3 << 11) | 20) & 0xFu; }
#define XB_SPIN(cond, bar) do { unsigned _sp = 0; while (cond) { __builtin_amdgcn_s_sleep(1); \
    if ((++_sp & 255u) == 0u) { if (xb_ld(&(bar)[XB_TMO])) break; if (_sp > XB_SPIN_CAP) { atomicAdd(&(bar)[XB_TMO], 1u); break; } } } } while (0)

struct XcdBarrier {
    unsigned* bar; unsigned x;
    volatile LAS unsigned* st;
};

__device__ __forceinline__ XcdBarrier xcd_barrier_post(unsigned* bar, volatile LAS unsigned* st) {
    XcdBarrier b; b.bar = bar; b.x = xb_xcc_id(); b.st = st;
    if (threadIdx.x == 0) (void)xb_add(&bar[XB_XCNT(b.x)], 1u);
    return b;
}
__device__ __forceinline__ void xcd_barrier_complete(unsigned* bar, unsigned x, unsigned& nloc, unsigned& nx) {
    const unsigned G = gridDim.x * gridDim.y * gridDim.z;
    unsigned sum, cnt, mine, sp = 0u;
    for (;;) {
        sum = 0u; cnt = 0u; mine = 0u;
#pragma unroll
        for (unsigned j = 0; j < 16; ++j) { const unsigned c = xb_ld(&bar[XB_XCNT(j)]); sum += c; cnt += (c > 0u) ? 1u : 0u; mine = (j == x) ? c : mine; }
        if (sum == G) break;
        __builtin_amdgcn_s_sleep(1);
        if ((++sp & 255u) == 0u) { if (xb_ld(&bar[XB_TMO])) break; if (sp > XB_SPIN_CAP) { atomicAdd(&bar[XB_TMO], 1u); break; } }
    }
    nloc = mine > 0u ? mine : 1u; nx = cnt > 0u ? cnt : 1u;
}

__device__ __forceinline__ void xcd_barrier(const XcdBarrier& b) {
    asm volatile("s_waitcnt vmcnt(0)" ::: "memory");
    __syncthreads();
    if (threadIdx.x == 0) {
        unsigned* bar = b.bar;
        __builtin_amdgcn_s_waitcnt(0);
        unsigned nloc = b.st[0], nx = b.st[1];
        if (nloc == 0u) { xcd_barrier_complete(bar, b.x, nloc, nx); b.st[0] = nloc; b.st[1] = nx; }
        const unsigned old = xb_add(&bar[XB_XSUB(b.x)], 1u);
        const unsigned gen = old / nloc;
        if (old + 1u == (gen + 1u) * nloc) {
            __builtin_amdgcn_fence(__ATOMIC_RELEASE, "agent");
            asm volatile("s_waitcnt vmcnt(0)" ::: "memory");
            const unsigned og = xb_add(&bar[XB_TOP], 1u);
            const unsigned tg = og / nx;
            if (og + 1u == (tg + 1u) * nx) xb_add(&bar[XB_TOPGEN], 1u);
            else XB_SPIN(xb_ld(&bar[XB_TOPGEN]) == tg, bar);
            __builtin_amdgcn_fence(__ATOMIC_ACQUIRE, "agent");
            xb_add(&bar[XB_XGEN(b.x)], 1u);
            asm volatile("s_waitcnt vmcnt(0)" ::: "memory");
        } else {
            XB_SPIN(xb_ld(&bar[XB_XGEN(b.x)]) == gen, bar);
            __builtin_amdgcn_fence(__ATOMIC_ACQUIRE, "agent");
            asm volatile("s_waitcnt vmcnt(0)" ::: "memory");
        }
    }
    __syncthreads();
}

__device__ __forceinline__ void xcd_barrier_flatrel(const XcdBarrier& b, unsigned& kcount) {
    asm volatile("s_waitcnt vmcnt(0)" ::: "memory");
    __syncthreads();
    if (threadIdx.x == 0) {
        unsigned* bar = b.bar;
        __builtin_amdgcn_s_waitcnt(0);
        unsigned nloc = b.st[0], nx = b.st[1];
        if (nloc == 0u) { xcd_barrier_complete(bar, b.x, nloc, nx); b.st[0] = nloc; b.st[1] = nx; }
        const unsigned old = xb_add(&bar[XB_XSUB(b.x)], 1u);
        const unsigned gen = old / nloc;
        if (old + 1u == (gen + 1u) * nloc) {
            __builtin_amdgcn_fence(__ATOMIC_RELEASE, "agent");
            asm volatile("s_waitcnt vmcnt(0)" ::: "memory");
            const unsigned og = xb_add(&bar[XB_TOP], 1u);
            const unsigned tg = og / nx;
            if (og + 1u == (tg + 1u) * nx) xb_add(&bar[XB_TOPGEN], 1u);
        }
        const unsigned want = kcount + 1u;
        XB_SPIN(xb_ld(&bar[XB_TOPGEN]) < want, bar);
        __builtin_amdgcn_fence(__ATOMIC_ACQUIRE, "agent");
        asm volatile("s_waitcnt vmcnt(0)" ::: "memory");
    }
    __syncthreads();
    ++kcount;
}

constexpr int STG_ROW = 144, STG_BYTES = 32 * STG_ROW;
__device__ __forceinline__ void stage_write(ldsp st, const f32x16 (&o)[2], int r32, int hi) {
#pragma unroll
    for (int vt = 0; vt < 2; ++vt)
#pragma unroll
        for (int g = 0; g < 4; ++g) { u32x2 w; w.x = pk2(o[vt][4 * g], o[vt][4 * g + 1]); w.y = pk2(o[vt][4 * g + 2], o[vt][4 * g + 3]);
            lds_st<u32x2>(st, r32 * STG_ROW + (32 * vt + 8 * g + 4 * hi) * 2, w); }
}
__device__ __forceinline__ void load8f(const float* p, float (&o)[8]) { const f32x4 a = *(const f32x4*)p, b = *(const f32x4*)(p + 4); o[0] = a.x; o[1] = a.y; o[2] = a.z; o[3] = a.w; o[4] = b.x; o[5] = b.y; o[6] = b.z; o[7] = b.w; }
__device__ __forceinline__ bf16x8 ldg_f32_as_bf16x8(const float* p) { const f32x4 a = *(const f32x4*)p, b = *(const f32x4*)(p + 4); return pack8(a.x, a.y, a.z, a.w, b.x, b.y, b.z, b.w); }
__device__ __forceinline__ u32x4 pack8u(const float (&v)[8]) { u32x4 w; w.x = pk2(v[0], v[1]); w.y = pk2(v[2], v[3]); w.z = pk2(v[4], v[5]); w.w = pk2(v[6], v[7]); return w; }


__device__ __forceinline__ void small_gates_unit(const Ctx& C0, const bf16* Xb, const bf16* Wt, const unsigned long long* rs, bf16* P, int unit) {
    const Ctx C = relaunder(C0);
    typedef float f32x4v __attribute__((ext_vector_type(4)));
    const int r16 = C.lane & 15, kq = C.lane >> 4, m0 = 16 * unit;
    const bf16* ap = Wt + (size_t)(NPG + r16) * D + 8 * kq; const bf16* bp = Xb + (size_t)(m0 + r16) * D + 8 * kq;
    f32x4v acc0 = (f32x4v){0.f, 0.f, 0.f, 0.f}, acc1 = acc0;
#pragma unroll 1
    for (int half = 0; half < 2; ++half) {
        bf16x8 a0[16], a1[16], bb[16];
#pragma unroll
        for (int s = 0; s < 16; ++s) { const int ko = 32 * (16 * half + s); a0[s] = *(const bf16x8*)(ap + ko); a1[s] = *(const bf16x8*)(ap + (size_t)16 * D + ko); bb[s] = *(const bf16x8*)(bp + ko); }
#pragma unroll
        for (int s = 0; s < 16; ++s) { acc0 = __builtin_amdgcn_mfma_f32_16x16x32_bf16(a0[s], bb[s], acc0, 0, 0, 0); acc1 = __builtin_amdgcn_mfma_f32_16x16x32_bf16(a1[s], bb[s], acc1, 0, 0, 0); }
    }
    const float rstd = rsqrtf((float)rs[m0 + r16] * (1.0f / 1048576.0f) * (1.0f / 1024.0f) + EPS);
    bf16* o = P + (size_t)(m0 + r16) * NP + NPG + 4 * kq;
    { u32x2 w; w.x = pk2(acc0[0] * rstd, acc0[1] * rstd); w.y = pk2(acc0[2] * rstd, acc0[3] * rstd); *(u32x2*)o = w; }
    if (kq < 2) { u32x2 w; w.x = pk2(acc1[0] * rstd, acc1[1] * rstd); w.y = pk2(acc1[2] * rstd, acc1[3] * rstd); *(u32x2*)(o + 16) = w; }
}
__device__ __forceinline__ f32x4 sc_cv(const bf16* P, int m, int c) {
    const u32x2 a = *(const u32x2*)(P + (size_t)m * NP + PC_DC + c), b = *(const u32x2*)(P + (size_t)m * NP + PC_DV + c);
    return (f32x4){lo16(a.x) * lo16(b.x), hi16(a.x) * hi16(b.x), lo16(a.y) * lo16(b.y), hi16(a.y) * hi16(b.y)};
}
__device__ __forceinline__ void sc_unit(const Ctx& C0, const bf16* P, bf16* Y, const float* cw, const float* gn, int wu) {
    const Ctx C = relaunder(C0);
    const int c = 4 * C.lane, m0 = 32 * wu, t0 = m0 & (L - 1);
    const f32x4 w0 = *(const f32x4*)(cw + c), w1 = *(const f32x4*)(cw + 256 + c), w2 = *(const f32x4*)(cw + 512 + c), g = *(const f32x4*)(gn + c);
    f32x4 p2 = (f32x4){0.f, 0.f, 0.f, 0.f}, p1 = p2;
    if (t0 > 0) { p2 = sc_cv(P, m0 - 2, c); p1 = sc_cv(P, m0 - 1, c); }
    for (int i = 0; i < 32; ++i) {
        const int m = m0 + i; const f32x4 cv = sc_cv(P, m, c);
        const u32x2 bb = *(const u32x2*)(P + (size_t)m * NP + PC_DB + c);
        const f32x4 bg = (f32x4){lo16(bb.x), hi16(bb.x), lo16(bb.y), hi16(bb.y)};
        const f32x4 y = bg * (w0 * p2 + w1 * p1 + w2 * cv);
        float ss = (y.x * y.x + y.y * y.y) + (y.z * y.z + y.w * y.w);
        ss += __shfl_xor(ss, 1); ss += __shfl_xor(ss, 2); ss += __shfl_xor(ss, 4); ss += __shfl_xor(ss, 8);
        const float rstd = rsqrtf(ss * (1.f / 64.f) + EPS);
        u32x2 w; w.x = pk2(y.x * rstd * g.x, y.y * rstd * g.y); w.y = pk2(y.z * rstd * g.z, y.w * rstd * g.w);
        *(u32x2*)(Y + (size_t)m * D + 768 + c) = w;
        p2 = p1; p1 = cv;
    }
}
__device__ __forceinline__ void foxprep_unit(const Ctx& C0, const bf16* P, bf16* Vt, float* Fraw, const float* bfor, int wu) {
    const Ctx C = relaunder(C0);
    const int lane = C.lane, c = 4 * lane, h = lane >> 4, d = c & 63, m0 = 32 * wu, b = m0 / L, t0 = m0 & (L - 1);
    for (int i8 = 0; i8 < 4; ++i8) {
        u32x2 vraw[8];
#pragma unroll
        for (int j = 0; j < 8; ++j) vraw[j] = *(const u32x2*)(P + (size_t)(m0 + 8 * i8 + j) * NP + PC_BV + c);
        bf16* vrow = Vt + ((size_t)((b * 4 + h) * 64 + d)) * L + t0 + 8 * i8;
        u32x4 e0, e1, e2, e3;
#define FP_LO(a, b) (((a) & 0xffffu) | ((b) << 16))
#define FP_HI(a, b) (((a) >> 16) | ((b) & 0xffff0000u))
        e0.x = FP_LO(vraw[0].x, vraw[1].x); e0.y = FP_LO(vraw[2].x, vraw[3].x); e0.z = FP_LO(vraw[4].x, vraw[5].x); e0.w = FP_LO(vraw[6].x, vraw[7].x);
        e1.x = FP_HI(vraw[0].x, vraw[1].x); e1.y = FP_HI(vraw[2].x, vraw[3].x); e1.z = FP_HI(vraw[4].x, vraw[5].x); e1.w = FP_HI(vraw[6].x, vraw[7].x);
        e2.x = FP_LO(vraw[0].y, vraw[1].y); e2.y = FP_LO(vraw[2].y, vraw[3].y); e2.z = FP_LO(vraw[4].y, vraw[5].y); e2.w = FP_LO(vraw[6].y, vraw[7].y);
        e3.x = FP_HI(vraw[0].y, vraw[1].y); e3.y = FP_HI(vraw[2].y, vraw[3].y); e3.z = FP_HI(vraw[4].y, vraw[5].y); e3.w = FP_HI(vraw[6].y, vraw[7].y);
#undef FP_LO
#undef FP_HI
        *(u32x4*)(vrow) = e0; *(u32x4*)(vrow + L) = e1; *(u32x4*)(vrow + 2 * L) = e2; *(u32x4*)(vrow + 3 * L) = e3;
        if (lane < 32) { const int j = lane >> 2, hh = lane & 3; const int m = m0 + 8 * i8 + j;
            const float f = bf2f(P[(size_t)m * NP + PC_BF + hh]) + bfor[hh];
            Fraw[(size_t)(b * 4 + hh) * L + t0 + 8 * i8 + j] = logsigmoid(f); }
    }
}

constexpr int G_QD = 0, G_KD = 33792, G_VT = 67584, G_GLR = 104448, G_TOT = 108544, G_STG = 110592;
constexpr int GROW = 528, TROW = 144;
__device__ __forceinline__ void gla_gate(const Ctx& C, ldsp ZB, ldsp TOT, const bf16* P, const float* w2g, const float* bgate, int m0, int c, int th, float (&bb)[32], float& blast) {
    { const int w = C.wave, r32 = C.lane & 31, hi = C.lane >> 5, ch = 32 * w + r32;
      const bf16x8 a0 = *(const bf16x8*)(P + (size_t)(m0 + r32) * NP + PC_ALR + 8 * hi), a1 = *(const bf16x8*)(P + (size_t)(m0 + 32 + r32) * NP + PC_ALR + 8 * hi);
      float wv[8];
#pragma unroll
      for (int j = 0; j < 8; ++j) wv[j] = w2g[(8 * hi + j) * 256 + ch];
      const bf16x8 bfr = __builtin_bit_cast(bf16x8, pack8u(wv)); const float bgv = bgate[ch];
      const f32x16 z0 = MFMA32(a0, bfr, (f32x16){}), z1 = MFMA32(a1, bfr, (f32x16){});
#pragma unroll
      for (int r = 0; r < 16; ++r) { lds_st<bf16>(ZB, crow(r, hi) * GROW + ch * 2, f2bf(z0[r] + bgv)); lds_st<bf16>(ZB, (32 + crow(r, hi)) * GROW + ch * 2, f2bf(z1[r] + bgv)); } }
    __syncthreads();
    float run = 0.f;
#pragma unroll
    for (int i = 0; i < 32; ++i) { const float z = bf2f(lds_ld<bf16>(ZB, (32 * th + i) * GROW + c * 2));
        run += (fminf(z, 0.f) - __logf(1.0f + __expf(-fabsf(z)))) * (1.f / 16.f); bb[i] = run; }
    lds_st<float>(TOT, (th * 256 + c) * 4, run);
    __syncthreads();
    const float t0 = lds_ld<float>(TOT, c * 4), t1 = lds_ld<float>(TOT, (256 + c) * 4);
    if (th) {
#pragma unroll
        for (int i = 0; i < 32; ++i) bb[i] += t0;
    }
    blast = t0 + t1;
}
__device__ __forceinline__ void gla_passA(const Ctx& C0, const bf16* P, float* GST, float* GD, const float* w2g, const float* bgate, int unit) {
    const Ctx C = relaunder(C0);
    const int b = unit >> 7, n = unit & 127, m0 = b * L + 64 * n, c = C.tid & 255, th = C.tid >> 8;
    __syncthreads();
    const ldsp QD = lds_opaque(C.lds + G_QD), KD = lds_opaque(C.lds + G_KD), VT_ = lds_opaque(C.lds + G_VT), GLR = lds_opaque(C.lds + G_STG), TOT = lds_opaque(C.lds + G_TOT);
    bf16 rk[32], rv[32];
#pragma unroll
    for (int i = 0; i < 32; ++i) { const size_t ro = (size_t)(m0 + 32 * th + i) * NP; rk[i] = P[ro + PC_AK + c]; rv[i] = P[ro + PC_AV + c]; }
    float bb[32], blast; gla_gate(C, GLR, TOT, P, w2g, bgate, m0, c, th, bb, blast);
#pragma unroll
    for (int i8 = 0; i8 < 4; ++i8) { float kk[8], vv[8];
#pragma unroll
        for (int j = 0; j < 8; ++j) { kk[j] = bf2f(rk[8 * i8 + j]) * __expf(blast - bb[8 * i8 + j]); vv[j] = bf2f(rv[8 * i8 + j]); }
        lds_st<u32x4>(QD, c * TROW + (32 * th + 8 * i8) * 2, pack8u(kk)); lds_st<u32x4>(VT_, c * TROW + (32 * th + 8 * i8) * 2, pack8u(vv)); }
    if (th == 0) GD[(size_t)((b * 128 + n) * 4 + (c >> 6)) * 64 + (c & 63)] = __expf(blast);
    __syncthreads();
    const int w = C.wave, h = w >> 1, dt = w & 1, r32 = C.lane & 31, hi = C.lane >> 5;
    f32x16 acc[2]; acc[0] = (f32x16){}; acc[1] = (f32x16){};
#pragma unroll
    for (int s = 0; s < 4; ++s) { const bf16x8 bf = lds_ld<bf16x8>(QD, (h * 64 + 32 * dt + r32) * TROW + (16 * s + 8 * hi) * 2);
#pragma unroll
        for (int vt = 0; vt < 2; ++vt) { const bf16x8 af = lds_ld<bf16x8>(VT_, (h * 64 + 32 * vt + r32) * TROW + (16 * s + 8 * hi) * 2); acc[vt] = MFMA32(af, bf, acc[vt]); } }
    float* st = GST + (size_t)((b * 128 + n) * 4 + h) * 4096;
#pragma unroll
    for (int vt = 0; vt < 2; ++vt)
#pragma unroll
        for (int r = 0; r < 16; ++r) st[(32 * vt + crow(r, hi)) * 64 + 32 * dt + r32] = acc[vt][r];
}
__device__ __forceinline__ void gla_passC(const Ctx& C0, const bf16* P, const bf16* GSB, bf16* Y, const float* w2g, const float* bgate, const float* gnorm, int unit) {
    const Ctx C = relaunder(C0);
    const int b = unit >> 7, n = unit & 127, m0 = b * L + 64 * n, c = C.tid & 255, th = C.tid >> 8;
    __syncthreads();
    const ldsp QD = lds_opaque(C.lds + G_QD), KD = lds_opaque(C.lds + G_KD), VT_ = lds_opaque(C.lds + G_VT), GLR = lds_opaque(C.lds + G_STG), TOT = lds_opaque(C.lds + G_TOT);
    bf16x8 sfr[2][4];
    { const int w_ = C.wave, h_ = w_ >> 1, r32_ = C.lane & 31, hi_ = C.lane >> 5; const bf16* stb = GSB + (size_t)((b * 128 + n) * 4 + h_) * 4096;
#pragma unroll
      for (int vt = 0; vt < 2; ++vt)
#pragma unroll
        for (int s_ = 0; s_ < 4; ++s_) sfr[vt][s_] = *(const bf16x8*)(stb + (32 * vt + r32_) * 64 + 16 * s_ + 8 * hi_); }
    { bf16 rq[32], rk[32], rv[32];
#pragma unroll
      for (int i = 0; i < 32; ++i) { const size_t ro = (size_t)(m0 + 32 * th + i) * NP; rq[i] = P[ro + PC_AQ + c]; rk[i] = P[ro + PC_AK + c]; rv[i] = P[ro + PC_AV + c]; }
      float bb[32], blast; gla_gate(C, GLR, TOT, P, w2g, bgate, m0, c, th, bb, blast);
#pragma unroll
      for (int i8 = 0; i8 < 4; ++i8) { float vv[8];
#pragma unroll
        for (int j = 0; j < 8; ++j) { const int t = 32 * th + 8 * i8 + j; const float e = __expf(bb[8 * i8 + j]), ei = __expf(-bb[8 * i8 + j]);
            const float q = bf2f(rq[8 * i8 + j]) * 0.125f * e, k = bf2f(rk[8 * i8 + j]) * ei; vv[j] = bf2f(rv[8 * i8 + j]);
            lds_st<bf16>(QD, t * GROW + c * 2, f2bf(q)); lds_st<bf16>(KD, t * GROW + c * 2, f2bf(k)); }
        lds_st<u32x4>(VT_, c * TROW + (32 * th + 8 * i8) * 2, pack8u(vv)); } }
    __syncthreads();
    const int w = C.wave, h = w >> 1, ih = w & 1, r32 = C.lane & 31, hi = C.lane >> 5;
    bf16x8 qf[4];
#pragma unroll
    for (int s = 0; s < 4; ++s) qf[s] = lds_ld<bf16x8>(QD, (32 * ih + r32) * GROW + (h * 64 + 16 * s + 8 * hi) * 2);
    f32x16 o[2]; o[0] = (f32x16){}; o[1] = (f32x16){};
    u32x4 gpre[4];
#pragma unroll
    for (int it = 0; it < 4; ++it) gpre[it] = *(const u32x4*)(P + (size_t)(m0 + 32 * ih + 8 * it + (C.lane >> 3)) * NP + PC_AG + h * 64 + 8 * (C.lane & 7));
#pragma unroll
    for (int vt = 0; vt < 2; ++vt)
#pragma unroll
        for (int s = 0; s < 4; ++s) o[vt] = MFMA32(sfr[vt][s], qf[s], o[vt]);
    for (int jt = 0; jt <= ih; ++jt) {
        f32x16 X = (f32x16){};
#pragma unroll
        for (int s = 0; s < 4; ++s) { const bf16x8 kf = lds_ld<bf16x8>(KD, (32 * jt + r32) * GROW + (h * 64 + 16 * s + 8 * hi) * 2); X = MFMA32(kf, qf[s], X); }
        if (jt == ih) {
#pragma unroll
            for (int r = 0; r < 16; ++r) if (crow(r, hi) > r32) X[r] = 0.f;
        }
#pragma unroll
        for (int s2 = 0; s2 < 2; ++s2) { const bf16x8 pf = pack8(X[8 * s2], X[8 * s2 + 1], X[8 * s2 + 2], X[8 * s2 + 3], X[8 * s2 + 4], X[8 * s2 + 5], X[8 * s2 + 6], X[8 * s2 + 7]);
#pragma unroll
            for (int vt = 0; vt < 2; ++vt) { const int ao = (h * 64 + 32 * vt + r32) * TROW + (32 * jt + 16 * s2 + 4 * hi) * 2;
                const bf16x8 af = cat2(lds_ld<u32x2>(VT_, ao), lds_ld<u32x2>(VT_, ao + 16)); o[vt] = MFMA32(af, pf, o[vt]); } }
    }
    ldsp stg = C.lds + G_STG + w * STG_BYTES;
    stage_write(stg, o, r32, hi);
    asm volatile("s_waitcnt lgkmcnt(0)" ::: "memory");
#pragma unroll
    for (int it = 0; it < 4; ++it) { const int row = 8 * it + (C.lane >> 3), ch = 8 * (C.lane & 7); const int m = m0 + 32 * ih + row;
        float y[8], gt[8], gn[8]; unpack8(lds_ld<u32x4>(stg, row * STG_ROW + ch * 2), y); unpack8(gpre[it], gt); load8f(gnorm + h * 64 + ch, gn);
        float ss = 0.f;
#pragma unroll
        for (int e = 0; e < 8; ++e) ss += y[e] * y[e];
        ss += __shfl_xor(ss, 1); ss += __shfl_xor(ss, 2); ss += __shfl_xor(ss, 4);
        const float rstd = rsqrtf(ss * (1.f / 64.f) + EPS);
#pragma unroll
        for (int e = 0; e < 8; ++e) y[e] = y[e] * rstd * gn[e] * silu(gt[e]);
        *(u32x4*)(Y + (size_t)m * D + h * 64 + ch) = pack8u(y); }
}

constexpr int S_B = 0, S_C = 34816, S_X = 69632, S_AS = 104448, S_DT = 105472, S_ACS = 106496, S_SSX = 107520, S_STG = 108544;
constexpr int SROW = 272;
__device__ __forceinline__ void ssd_dt(const Ctx& C, ldsp SM, const bf16* P, const float* dtb, const float* Alog, int m0, int g) {
    const int hh = (C.tid >> 7) & 1, j = C.tid & 127;
    if (C.tid < 256) { const int h = 2 * g + hh; const float dtv = softplus(bf2f(P[(size_t)(m0 + j) * NP + PC_DT + h]) + dtb[h]);
        lds_st<float>(SM, (S_DT - S_AS) + (hh * 128 + j) * 4, dtv); lds_st<float>(SM, (S_AS - S_AS) + (hh * 128 + j) * 4, -__expf(Alog[h]) * dtv); }
    __syncthreads();
    if (C.tid < 256) { float v = lds_ld<float>(SM, (S_AS - S_AS) + (hh * 128 + j) * 4);
#pragma unroll
        for (int o_ = 1; o_ < 64; o_ <<= 1) { const float t_ = __shfl_up(v, o_); if (C.lane >= o_) v += t_; }
        if ((j & 64) == 0 && C.lane == 63) lds_st<float>(SM, (S_SSX - S_AS) + hh * 4, v);
        lds_st<float>(SM, (S_ACS - S_AS) + (hh * 128 + j) * 4, v); }
    __syncthreads();
    if (C.tid < 256 && (j & 64)) lds_st<float>(SM, (S_ACS - S_AS) + (hh * 128 + j) * 4, lds_ld<float>(SM, (S_ACS - S_AS) + (hh * 128 + j) * 4) + lds_ld<float>(SM, (S_SSX - S_AS) + hh * 4));
    __syncthreads();
}
template <bool PASS_C>
__device__ __forceinline__ void ssd_issue(const Ctx& C, const bf16* P, int m0, int n, int g, bf16 (&rawa)[PASS_C ? 3 : 2][35]) {
    constexpr int NCH = PASS_C ? 384 : 256, NIT = PASS_C ? 3 : 2;
#pragma unroll
    for (int k = 0; k < NIT; ++k) {
        const int item = C.tid + NTHREADS * k, ch = item % NCH, tq = item / NCH, typ = ch >> 7, cc = ch & 127, ci = typ * 256 + g * 128 + cc, pcol = PC_XBC + ci, j0 = 32 * tq;
        const bf16* pp = P + ((ptrdiff_t)(m0 + j0) - 3) * NP + pcol; const bool hasprev = (128 * n + j0 > 0);
#pragma unroll
        for (int t_ = 0; t_ < 35; ++t_) rawa[k][t_] = (t_ >= 3 || hasprev) ? pp[(ptrdiff_t)t_ * NP] : (bf16)0;
    }
}
template <bool PASS_C>
__device__ __forceinline__ void ssd_load(const Ctx& C, ldsp SB, ldsp SC, ldsp SX, ldsp SM, const bf16 (&rawa)[PASS_C ? 3 : 2][35], bf16* XS, const float* cw, const float* cb, int m0, int n, int g) {
    constexpr int NCH = PASS_C ? 384 : 256, NIT = PASS_C ? 3 : 2;
#pragma unroll
    for (int k = 0; k < NIT; ++k) {
        const int item = C.tid + NTHREADS * k, ch = item % NCH, tq = item / NCH, typ = ch >> 7, cc = ch & 127, ci = typ * 256 + g * 128 + cc;
        const float w0 = cw[ci], w1 = cw[768 + ci], w2 = cw[1536 + ci], w3 = cw[2304 + ci], bias = cb[ci];
        const int j0 = 32 * tq, hh = cc >> 6;
        const bf16 (&raw)[35] = rawa[k];
        float u3 = bf2f(raw[0]), u2 = bf2f(raw[1]), u1 = bf2f(raw[2]);
        const float alast = lds_ld<float>(SM, (S_ACS - S_AS) + (hh * 128 + 127) * 4);
#pragma unroll
        for (int i8 = 0; i8 < 4; ++i8) { float yv[8];
#pragma unroll
            for (int j = 0; j < 8; ++j) { const float u0 = bf2f(raw[3 + 8 * i8 + j]);
                yv[j] = silu(w0 * u3 + w1 * u2 + w2 * u1 + w3 * u0 + bias); u3 = u2; u2 = u1; u1 = u0; }
            const int jb = j0 + 8 * i8;
            if (typ == 0) {
#pragma unroll
                for (int j = 0; j < 8; ++j) { const float dtv = lds_ld<float>(SM, (S_DT - S_AS) + (hh * 128 + jb + j) * 4);
                    if (!PASS_C) { XS[(size_t)(m0 + jb + j) * 256 + g * 128 + cc] = f2bf(yv[j]); yv[j] *= dtv * __expf(alast - lds_ld<float>(SM, (S_ACS - S_AS) + (hh * 128 + jb + j) * 4)); }
                    else yv[j] *= dtv; }
                lds_st<u32x4>(SX, cc * SROW + jb * 2, pack8u(yv));
            } else if (!PASS_C) { lds_st<u32x4>(SB, cc * SROW + jb * 2, pack8u(yv)); }
            else { const ldsp base = (typ == 1) ? SB : SC;
#pragma unroll
                for (int j = 0; j < 8; ++j) lds_st<bf16>(base, (jb + j) * SROW + cc * 2, f2bf(yv[j])); }
        }
    }
}
__device__ __forceinline__ void ssd_passA(const Ctx& C0, const bf16* P, bf16* XS, float* SST, float* SD, const float* cw, const float* cb, const float* dtb, const float* Alog, int unit) {
    const Ctx C = relaunder(C0);
    const int b = unit >> 7, n = (unit >> 1) & 63, g = unit & 1, m0 = b * L + 128 * n;
    __syncthreads();
    const ldsp SB = lds_opaque(C.lds + S_B), SC = lds_opaque(C.lds + S_C), SX = lds_opaque(C.lds + S_X), SM = lds_opaque(C.lds + S_AS);
    bf16 rawa[2][35]; ssd_issue<false>(C, P, m0, n, g, rawa);
    ssd_dt(C, SM, P, dtb, Alog, m0, g);
    ssd_load<false>(C, SB, SC, SX, SM, rawa, XS, cw, cb, m0, n, g);
    if (C.tid < 2) SD[(size_t)(b * 64 + n) * 4 + 2 * g + C.tid] = __expf(lds_ld<float>(SM, (S_ACS - S_AS) + (C.tid * 128 + 127) * 4));
    __syncthreads();
    const int w = C.wave, hh = w >> 2, nt = w & 3, r32 = C.lane & 31, hi = C.lane >> 5;
    f32x16 acc[2]; acc[0] = (f32x16){}; acc[1] = (f32x16){};
#pragma unroll
    for (int s = 0; s < 8; ++s) { const bf16x8 bf = lds_ld<bf16x8>(SB, (32 * nt + r32) * SROW + (16 * s + 8 * hi) * 2);
#pragma unroll
        for (int pt = 0; pt < 2; ++pt) { const bf16x8 af = lds_ld<bf16x8>(SX, (hh * 64 + 32 * pt + r32) * SROW + (16 * s + 8 * hi) * 2); acc[pt] = MFMA32(af, bf, acc[pt]); } }
    float* st = SST + (size_t)((b * 64 + n) * 4 + 2 * g + hh) * 8192;
#pragma unroll
    for (int pt = 0; pt < 2; ++pt)
#pragma unroll
        for (int r = 0; r < 16; ++r) st[(32 * pt + crow(r, hi)) * 128 + 32 * nt + r32] = acc[pt][r];
}
__device__ __forceinline__ void ssd_passC(const Ctx& C0, const bf16* P, const bf16* XS, const bf16* SSB, bf16* Y, const float* cw, const float* cb, const float* dtb, const float* Alog, const float* Dsk, const float* gnorm, int unit) {
    const Ctx C = relaunder(C0);
    const int b = unit >> 7, n = (unit >> 1) & 63, g = unit & 1, m0 = b * L + 128 * n;
    __syncthreads();
    const ldsp SB = lds_opaque(C.lds + S_B), SC = lds_opaque(C.lds + S_C), SX = lds_opaque(C.lds + S_X), SM = lds_opaque(C.lds + S_AS);
    bf16x8 sfr[2][8];
    { const int w_ = C.wave, hh_ = w_ >> 2, r32_ = C.lane & 31, hi_ = C.lane >> 5; const bf16* stb = SSB + (size_t)((b * 64 + n) * 4 + 2 * g + hh_) * 8192;
#pragma unroll
      for (int pt = 0; pt < 2; ++pt)
#pragma unroll
        for (int s_ = 0; s_ < 8; ++s_) sfr[pt][s_] = *(const bf16x8*)(stb + (32 * pt + r32_) * 128 + 16 * s_ + 8 * hi_); }
    bf16 rawa[3][35]; ssd_issue<true>(C, P, m0, n, g, rawa);
    ssd_dt(C, SM, P, dtb, Alog, m0, g);
    ssd_load<true>(C, SB, SC, SX, SM, rawa, nullptr, cw, cb, m0, n, g);
    __syncthreads();
    const int w = C.wave, hh = w >> 2, it = w & 3, r32 = C.lane & 31, hi = C.lane >> 5, h = 2 * g + hh;
    const float acs_i = lds_ld<float>(SM, (S_ACS - S_AS) + (hh * 128 + 32 * it + r32) * 4);
    f32x16 o[2]; o[0] = (f32x16){}; o[1] = (f32x16){};
    u32x4 xpre[4], zpre[4];
#pragma unroll
    for (int q4 = 0; q4 < 4; ++q4) { const int m_ = m0 + 32 * it + 8 * q4 + (C.lane >> 3); const int ch_ = 8 * (C.lane & 7);
        xpre[q4] = *(const u32x4*)(XS + (size_t)m_ * 256 + g * 128 + hh * 64 + ch_); zpre[q4] = *(const u32x4*)(P + (size_t)m_ * NP + PC_CZ + g * 128 + hh * 64 + ch_); }
#pragma unroll
    for (int s = 0; s < 8; ++s) { const bf16x8 cf = lds_ld<bf16x8>(SC, (32 * it + r32) * SROW + (16 * s + 8 * hi) * 2);
#pragma unroll
        for (int pt = 0; pt < 2; ++pt) o[pt] = MFMA32(sfr[pt][s], cf, o[pt]); }
    { const float ei = __expf(acs_i);
#pragma unroll
      for (int r = 0; r < 16; ++r) { o[0][r] *= ei; o[1][r] *= ei; } }
    for (int jt = 0; jt <= it; ++jt) {
        f32x16 X = (f32x16){};
#pragma unroll
        for (int s = 0; s < 8; ++s) { const bf16x8 bf = lds_ld<bf16x8>(SB, (32 * jt + r32) * SROW + (16 * s + 8 * hi) * 2);
            const bf16x8 cf = lds_ld<bf16x8>(SC, (32 * it + r32) * SROW + (16 * s + 8 * hi) * 2); X = MFMA32(bf, cf, X); }
#pragma unroll
        for (int r = 0; r < 16; ++r) { const int jl = 32 * jt + crow(r, hi); const float aj = lds_ld<float>(SM, (S_ACS - S_AS) + (hh * 128 + jl) * 4);
            X[r] = (jl <= 32 * it + r32) ? X[r] * __expf(acs_i - aj) : 0.f; }
#pragma unroll
        for (int s2 = 0; s2 < 2; ++s2) { const bf16x8 pf = pack8(X[8 * s2], X[8 * s2 + 1], X[8 * s2 + 2], X[8 * s2 + 3], X[8 * s2 + 4], X[8 * s2 + 5], X[8 * s2 + 6], X[8 * s2 + 7]);
#pragma unroll
            for (int pt = 0; pt < 2; ++pt) { const int ao = (hh * 64 + 32 * pt + r32) * SROW + (32 * jt + 16 * s2 + 4 * hi) * 2;
                const bf16x8 af = cat2(lds_ld<u32x2>(SX, ao), lds_ld<u32x2>(SX, ao + 16)); o[pt] = MFMA32(af, pf, o[pt]); } }
    }
    ldsp stg = C.lds + S_STG + w * STG_BYTES;
    stage_write(stg, o, r32, hi);
    asm volatile("s_waitcnt lgkmcnt(0)" ::: "memory");
    float yy[4][8]; const float Dh = Dsk[h]; const int ch = 8 * (C.lane & 7);
#pragma unroll
    for (int q4 = 0; q4 < 4; ++q4) { const int row = 8 * q4 + (C.lane >> 3); const int m = m0 + 32 * it + row;
        float xs[8], z[8]; unpack8(lds_ld<u32x4>(stg, row * STG_ROW + ch * 2), yy[q4]); unpack8(xpre[q4], xs); unpack8(zpre[q4], z);
        float ss = 0.f;
#pragma unroll
        for (int e = 0; e < 8; ++e) { yy[q4][e] = (yy[q4][e] + xs[e] * Dh) * silu(z[e]); ss += yy[q4][e] * yy[q4][e]; }
        ss += __shfl_xor(ss, 1); ss += __shfl_xor(ss, 2); ss += __shfl_xor(ss, 4);
        if ((C.lane & 7) == 0) lds_st<float>(SM, (S_SSX - S_AS) + ((hh * 4 + it) * 32 + row) * 4, ss); }
    __syncthreads();
    float gn[8]; load8f(gnorm + g * 128 + hh * 64 + ch, gn);
#pragma unroll
    for (int q4 = 0; q4 < 4; ++q4) { const int row = 8 * q4 + (C.lane >> 3); const int m = m0 + 32 * it + row;
        const float ss = lds_ld<float>(SM, (S_SSX - S_AS) + ((0 * 4 + it) * 32 + row) * 4) + lds_ld<float>(SM, (S_SSX - S_AS) + ((1 * 4 + it) * 32 + row) * 4);
        const float rstd = rsqrtf(ss * (1.f / 128.f) + EPS);
#pragma unroll
        for (int e = 0; e < 8; ++e) yy[q4][e] = yy[q4][e] * rstd * gn[e];
        *(u32x4*)(Y + (size_t)m * D + 512 + g * 128 + hh * 64 + ch) = pack8u(yy[q4]); }
}

constexpr int F_FS = 0, F_BUF = 32768, F_KROW = 144, F_VROW = 400, F_KB = 192 * F_KROW, F_BUFB = F_KB + 64 * F_VROW, F_STG = F_BUF, F_FLAG = F_BUF + 2 * F_BUFB;
__device__ __forceinline__ u32x4 fox_knorm(u32x4 raw, const float (&g)[8]) {
    float v[8]; unpack8(raw, v); float ss = 0.f;
#pragma unroll
    for (int e = 0; e < 8; ++e) ss += v[e] * v[e];
    ss += __shfl_xor(ss, 1); ss += __shfl_xor(ss, 2); ss += __shfl_xor(ss, 4);
    const float r = rsqrtf(ss * (1.f / 64.f) + EPS);
#pragma unroll
    for (int e = 0; e < 8; ++e) v[e] = v[e] * r * g[e];
    return pack8u(v);
}
__device__ __forceinline__ void fox_attn_unit(const Ctx& C0, const bf16* P, const bf16* Vt, const float* Fl, bf16* Y, const float* qn, const float* kn, const float* on, int unit) {
    const Ctx C = relaunder(C0);
    const int bh = unit >> 5, qb = unit & 31, b = bh >> 2, h = bh & 3, q0 = qb * 256, nk = q0 + 256, w = C.wave, r32 = C.lane & 31, hi = C.lane >> 5;
    __syncthreads();
    const float* Flg = Fl + (size_t)bh * L;
    { f32x4 fv[4];
#pragma unroll
      for (int k = 0; k < 4; ++k) { const int i = 4 * C.tid + 4 * NTHREADS * k; if (i < nk) fv[k] = *(const f32x4*)(Flg + i); }
#pragma unroll
      for (int k = 0; k < 4; ++k) { const int i = 4 * C.tid + 4 * NTHREADS * k; if (i < nk) lds_st<f32x4>(C.lds, F_FS + i * 4, fv[k]); } }
    float gm = fabsf(qn[C.lane]), km = fabsf(kn[C.lane]);
#pragma unroll
    for (int o_ = 1; o_ < 64; o_ <<= 1) { gm = fmaxf(gm, __shfl_xor(gm, o_)); km = fmaxf(km, __shfl_xor(km, o_)); }
    __syncthreads();
    const int q0w = q0 + 32 * w, ktlast = (q0w + 31) >> 6, ktlast_b = 4 * qb + 3;
    const float TH = 16.f * LOG2E * gm * km + 64.f;
    int lo, lo_b;
    { const float Fq0 = lds_ld<float>(C.lds, F_FS + q0w * 4); int a_ = 0, hb = ktlast;
      while (a_ < hb) { const int mid = (a_ + hb) >> 1; if (Fq0 - lds_ld<float>(C.lds, F_FS + (64 * mid + 63) * 4) >= -TH) hb = mid; else a_ = mid + 1; } lo = a_; }
    { const float Fq0 = lds_ld<float>(C.lds, F_FS + q0 * 4); int a_ = 0, hb = q0 >> 6;
      while (a_ < hb) { const int mid = (a_ + hb) >> 1; if (Fq0 - lds_ld<float>(C.lds, F_FS + (64 * mid + 63) * 4) >= -TH) hb = mid; else a_ = mid + 1; } lo_b = a_; }
    const float Flq = lds_ld<float>(C.lds, F_FS + (q0w + r32) * 4);
    const size_t mb = (size_t)b * L;
    bf16x8 qr[4];
    { u32x4 qraw[4]; float qv[4][8], qg[4][8]; float ss = 0.f;
#pragma unroll
      for (int d0 = 0; d0 < 4; ++d0) { qraw[d0] = *(const u32x4*)(P + (mb + q0w + r32) * NP + PC_BQ + h * 64 + 16 * d0 + 8 * hi); load8f(qn + 16 * d0 + 8 * hi, qg[d0]); }
#pragma unroll
      for (int d0 = 0; d0 < 4; ++d0) { unpack8(qraw[d0], qv[d0]);
#pragma unroll
        for (int e = 0; e < 8; ++e) ss += qv[d0][e] * qv[d0][e]; }
      ss += __shfl_xor(ss, 32);
      const float rq = rsqrtf(ss * (1.f / 64.f) + EPS) * (0.125f * LOG2E);
#pragma unroll
      for (int d0 = 0; d0 < 4; ++d0) {
#pragma unroll
        for (int e = 0; e < 8; ++e) qv[d0][e] = qv[d0][e] * rq * qg[d0][e];
        qr[d0] = __builtin_bit_cast(bf16x8, pack8u(qv[d0])); } }
    float kg8[8]; load8f(kn + (C.tid & 7) * 8, kg8);
    float mrun = -INFINITY, lrun = 0.f; f32x16 o[2]; o[0] = (f32x16){}; o[1] = (f32x16){};
    const int qrow = q0w + r32;
    const int nch = (ktlast_b - lo_b + 3) / 3;
    u32x4 st[6];
    const bf16* kg = P + (mb + (C.tid >> 3)) * NP + PC_BK + h * 64 + (C.tid & 7) * 8;
    const int vd = C.tid / 24, vs = C.tid % 24;
    const ldsp BUF = lds_opaque(C.lds + F_BUF);
#define FOX_LOAD(c_) do { const int kt0_ = lo_b + 3 * (c_); \
        _Pragma("unroll") for (int i = 0; i < 3; ++i) { if (kt0_ + i <= ktlast_b) st[i] = *(const u32x4*)(kg + (size_t)(64 * (kt0_ + i)) * NP); } \
        _Pragma("unroll") for (int i = 0; i < 3; ++i) { const int p_ = C.tid + 512 * i, d_ = p_ / 24, sg_ = p_ % 24; if (kt0_ + (sg_ >> 3) <= ktlast_b) st[3 + i] = *(const u32x4*)(Vt + ((size_t)(bh * 64 + d_)) * L + 64 * kt0_ + sg_ * 8); } } while (0)
#define FOX_STORE(c_, par_) do { const int kt0_ = lo_b + 3 * (c_); const int bo_ = ((par_) & 1) * F_BUFB; \
        _Pragma("unroll") for (int i = 0; i < 3; ++i) { if (kt0_ + i <= ktlast_b) lds_st<u32x4>(BUF, bo_ + ((C.tid >> 3) + 64 * i) * F_KROW + (C.tid & 7) * 16, fox_knorm(st[i], kg8)); } \
        _Pragma("unroll") for (int i = 0; i < 3; ++i) { const int p_ = C.tid + 512 * i, d_ = p_ / 24, sg_ = p_ % 24; if (kt0_ + (sg_ >> 3) <= ktlast_b) lds_st<u32x4>(BUF, bo_ + F_KB + d_ * F_VROW + sg_ * 16, st[3 + i]); } } while (0)
    (void)vd; (void)vs;
    const float qkb = 8.f * LOG2E * gm * km;
    if (C.tid == 0) lds_st<unsigned>(C.lds, F_FLAG, 0u);
    FOX_LOAD(nch - 1); FOX_STORE(nch - 1, 0);
    __syncthreads();
    bool active = true;
    for (int ci = 0; ci < nch; ++ci) {
        const int c = nch - 1 - ci;
        if (c > 0) FOX_LOAD(c - 1);
        const int bo = (ci & 1) * F_BUFB;
        for (int tl = 2; tl >= 0; --tl) {
            const int kt = lo_b + 3 * c + tl;
            if (!active || kt > ktlast) continue;
            if (kt < lo || __all(qkb + (Flq - lds_ld<float>(C.lds, F_FS + (64 * kt + 63) * 4)) < mrun - 48.f)) {
                active = false; if (C.lane == 0) __hip_atomic_fetch_add((LAS unsigned*)(C.lds + F_FLAG), 1u, __ATOMIC_RELAXED, __HIP_MEMORY_SCOPE_WORKGROUP); continue; }
            const int kbase = bo + (64 * tl + r32) * F_KROW + 16 * hi;
            f32x16 s0 = (f32x16){}, s1 = (f32x16){};
#pragma unroll
            for (int d0 = 0; d0 < 4; ++d0) { const bf16x8 k0 = lds_ld<bf16x8>(BUF, kbase + 32 * d0), k1 = lds_ld<bf16x8>(BUF, kbase + 32 * F_KROW + 32 * d0); s0 = MFMA32(k0, qr[d0], s0); s1 = MFMA32(k1, qr[d0], s1); }
#pragma unroll
            for (int g = 0; g < 4; ++g) { const f32x4 fa = lds_ld<f32x4>(C.lds, F_FS + (64 * kt + 8 * g + 4 * hi) * 4), fb = lds_ld<f32x4>(C.lds, F_FS + (64 * kt + 32 + 8 * g + 4 * hi) * 4);
                s0[4 * g] += Flq - fa.x; s0[4 * g + 1] += Flq - fa.y; s0[4 * g + 2] += Flq - fa.z; s0[4 * g + 3] += Flq - fa.w;
                s1[4 * g] += Flq - fb.x; s1[4 * g + 1] += Flq - fb.y; s1[4 * g + 2] += Flq - fb.z; s1[4 * g + 3] += Flq - fb.w; }
            if (64 * kt + 63 > q0w) {
#pragma unroll
                for (int r = 0; r < 16; ++r) { const int key = 64 * kt + crow(r, hi); if (key > qrow) s0[r] = -INFINITY; if (key + 32 > qrow) s1[r] = -INFINITY; }
            }
            float mx = fmaxf(s0[0], s1[0]);
#pragma unroll
            for (int r = 1; r < 16; ++r) mx = fmaxf(mx, fmaxf(s0[r], s1[r]));
            mx = fmaxf(mx, __shfl_xor(mx, 32));
            const float mnew = fmaxf(mrun, mx), alpha = __builtin_amdgcn_exp2f(mrun - mnew); mrun = mnew;
            float rs = 0.f;
#pragma unroll
            for (int r = 0; r < 16; ++r) { s0[r] = __builtin_amdgcn_exp2f(s0[r] - mnew); s1[r] = __builtin_amdgcn_exp2f(s1[r] - mnew); rs += s0[r] + s1[r]; }
            lrun = lrun * alpha + rs;
#pragma unroll
            for (int r = 0; r < 16; ++r) { o[0][r] *= alpha; o[1][r] *= alpha; }
            const int vbase = bo + F_KB + r32 * F_VROW + (64 * tl + 4 * hi) * 2;
#pragma unroll
            for (int s2 = 0; s2 < 2; ++s2) {
                const bf16x8 p0 = pack8(s0[8 * s2], s0[8 * s2 + 1], s0[8 * s2 + 2], s0[8 * s2 + 3], s0[8 * s2 + 4], s0[8 * s2 + 5], s0[8 * s2 + 6], s0[8 * s2 + 7]);
                const bf16x8 p1 = pack8(s1[8 * s2], s1[8 * s2 + 1], s1[8 * s2 + 2], s1[8 * s2 + 3], s1[8 * s2 + 4], s1[8 * s2 + 5], s1[8 * s2 + 6], s1[8 * s2 + 7]);
#pragma unroll
                for (int dt = 0; dt < 2; ++dt) { const int vo = vbase + dt * 32 * F_VROW + 32 * s2;
                    const bf16x8 a0 = cat2(lds_ld<u32x2>(BUF, vo), lds_ld<u32x2>(BUF, vo + 16)), a1 = cat2(lds_ld<u32x2>(BUF, vo + 64), lds_ld<u32x2>(BUF, vo + 80));
                    o[dt] = MFMA32(a0, p0, o[dt]); o[dt] = MFMA32(a1, p1, o[dt]); }
            }
        }
        if (c > 0) FOX_STORE(c - 1, ci + 1);
        __syncthreads();
        if (lds_ld<unsigned>(C.lds, F_FLAG) >= 8u) break;
    }
    __syncthreads();
#undef FOX_LOAD
#undef FOX_STORE
    const float ltot = lrun + __shfl_xor(lrun, 32), inv = 1.0f / ltot;
#pragma unroll
    for (int r = 0; r < 16; ++r) { o[0][r] *= inv; o[1][r] *= inv; }
    ldsp stg = C.lds + F_STG + w * STG_BYTES;
    stage_write(stg, o, r32, hi);
    asm volatile("s_waitcnt lgkmcnt(0)" ::: "memory");
#pragma unroll
    for (int it = 0; it < 4; ++it) { const int row = 8 * it + (C.lane >> 3), ch = 8 * (C.lane & 7); const size_t m = mb + q0w + row;
        float y[8], gn[8]; unpack8(lds_ld<u32x4>(stg, row * STG_ROW + ch * 2), y); load8f(on + h * 64 + ch, gn);
        float ss = 0.f;
#pragma unroll
        for (int e = 0; e < 8; ++e) ss += y[e] * y[e];
        ss += __shfl_xor(ss, 1); ss += __shfl_xor(ss, 2); ss += __shfl_xor(ss, 4);
        const float rstd = rsqrtf(ss * (1.f / 64.f) + EPS);
#pragma unroll
        for (int e = 0; e < 8; ++e) y[e] = y[e] * rstd * gn[e];
        *(u32x4*)(Y + m * D + 256 + h * 64 + ch) = pack8u(y); }
}

__device__ __forceinline__ void scan_phase(const Ctx& C, const float* GST, const float* GD, bf16* GSB, const float* SST, const float* SD, bf16* SSB, const float* Fraw, float* Fl) {
    if (C.tid < 256) {
    for (int e = C.blk * 256 + C.tid; e < 65536; e += C.nblk * 256) { const int b = e >> 14, h = (e >> 12) & 3, vd = e & 4095, d = vd & 63;
        const float* p = GST + ((size_t)(b * 128) * 4 + h) * 4096 + vd; bf16* pb = GSB + ((size_t)(b * 128) * 4 + h) * 4096 + vd; const float* dp = GD + ((size_t)(b * 128) * 4 + h) * 64 + d; float S = 0.f;
        for (int n0 = 0; n0 < 128; n0 += 32) { float kv[32], dc[32];
#pragma unroll
            for (int j = 0; j < 32; ++j) { kv[j] = p[(size_t)(n0 + j) * 16384]; dc[j] = dp[(n0 + j) * 256]; }
#pragma unroll
            for (int j = 0; j < 32; ++j) { pb[(size_t)(n0 + j) * 16384] = f2bf(S); S = S * dc[j] + kv[j]; } } }
    } else {
    for (int e = C.blk * 256 + (C.tid - 256); e < 131072; e += C.nblk * 256) { const int b = e >> 15, h = (e >> 13) & 3, pn = e & 8191;
        const float* p = SST + ((size_t)(b * 64) * 4 + h) * 8192 + pn; bf16* pb = SSB + ((size_t)(b * 64) * 4 + h) * 8192 + pn; const float* dp = SD + (size_t)(b * 64) * 4 + h; float S = 0.f;
        for (int n0 = 0; n0 < 64; n0 += 32) { float kv[32], dc[32];
#pragma unroll
            for (int j = 0; j < 32; ++j) { kv[j] = p[(size_t)(n0 + j) * 32768]; dc[j] = dp[(n0 + j) * 4]; }
#pragma unroll
            for (int j = 0; j < 32; ++j) { pb[(size_t)(n0 + j) * 32768] = f2bf(S); S = S * dc[j] + kv[j]; } } }
    }
    for (int bh = C.blk; bh < 16; bh += C.nblk) {
        __syncthreads();
        const float* src = Fraw + (size_t)bh * L + 16 * C.tid; float v[16]; float run = 0.f;
#pragma unroll
        for (int j4 = 0; j4 < 4; ++j4) { const f32x4 a = *(const f32x4*)(src + 4 * j4); run += a.x; v[4 * j4] = run; run += a.y; v[4 * j4 + 1] = run; run += a.z; v[4 * j4 + 2] = run; run += a.w; v[4 * j4 + 3] = run; }
        float incl = run;
#pragma unroll
        for (int o_ = 1; o_ < 64; o_ <<= 1) { const float t_ = __shfl_up(incl, o_); if (C.lane >= o_) incl += t_; }
        if (C.lane == 63) lds_st<float>(C.lds, C.wave * 4, incl);
        __syncthreads();
        float pre = incl - run;
        for (int w_ = 0; w_ < C.wave; ++w_) pre += lds_ld<float>(C.lds, w_ * 4);
        float* dst = Fl + (size_t)bh * L + 16 * C.tid;
#pragma unroll
        for (int j4 = 0; j4 < 4; ++j4) *(f32x4*)(dst + 4 * j4) = (f32x4){(pre + v[4 * j4]) * LOG2E, (pre + v[4 * j4 + 1]) * LOG2E, (pre + v[4 * j4 + 2]) * LOG2E, (pre + v[4 * j4 + 3]) * LOG2E};
    }
}

#ifndef MK_PER_PHASE
#define MK_PER_PHASE 0
#endif
#ifndef PH_MASK
#define PH_MASK 0xffff
#endif
#define EN(k) ((PH_MASK >> (k)) & 1)
#ifndef DUP
#define DUP 0
#endif
#define DUPN(k) (((DUP >> (k)) & 1) ? 2 : 1)
#ifndef DUPT
#define DUPT -1
#endif
#define REPT(k) for (int rt_ = 0; rt_ < ((DUPT == (k)) ? 2 : 1); ++rt_)
constexpr int NPHASE = 1 + 9 * NLAYER;

__global__ void __launch_bounds__(NTHREADS) mega(Args a) {
    extern __shared__ __attribute__((aligned(16))) unsigned char lds_raw[];
    cg::grid_group grid = cg::this_grid();
    LAS unsigned char* glds = (LAS unsigned char*)lds_raw;
    float* X = a.out;
    volatile LAS unsigned* bst = (volatile LAS unsigned*)((ldsp)lds_raw + LDS_BYTES - 64);
    if (threadIdx.x < 16) bst[threadIdx.x] = 0u;
    __syncthreads();
    XcdBarrier bar = xcd_barrier_post((unsigned*)a.ws, bst); unsigned nbar = 0u;

    if (a.ph_hi < 0) grid.sync();
    for (int ph = a.ph_lo; ph < a.ph_hi; ++ph) {
        Ctx C; { int tid_ = threadIdx.x, blk_ = blockIdx.x, nblk_ = gridDim.x; unsigned char* ws_ = a.ws;
            asm volatile("" : "+v"(tid_)); asm volatile("" : "+s"(blk_), "+s"(nblk_), "+s"(ws_));
            C.ws = ws_; C.lds = (ldsp)lds_raw; C.tid = tid_; C.lane = tid_ & 63; C.wave = __builtin_amdgcn_readfirstlane(tid_ >> 6); C.nblk = nblk_; C.blk = blk_; }
        unsigned char* ws = C.ws;
        bf16* XN = (bf16*)(ws + WS_XN); bf16* HP = (bf16*)(ws + WS_HP); bf16* VT = (bf16*)(ws + WS_VT); bf16* YB = (bf16*)X; bf16* GSB = (bf16*)((unsigned char*)X + 64 * MiB); bf16* SSB = (bf16*)((unsigned char*)X + 80 * MiB);
        float* GST = (float*)(ws + WS_GST); float* GD = (float*)(ws + WS_GD); float* SST = (float*)(ws + WS_SST); float* SD = (float*)(ws + WS_SD);
        float* FRAW = (float*)(ws + WS_FRAW); float* FL = (float*)(ws + WS_FL); bf16* XS = (bf16*)(ws + WS_XS); unsigned long long* RS = (unsigned long long*)(ws + WS_RS);
        if (ph == 0) {
            for (int rep = 0; rep < DUPN(6); ++rep) { if (EN(0)) prologue(C, a); }
            for (int i = C.blk * NTHREADS + C.tid; i < (NLAYER * 3 - 1) * M / 2; i += C.nblk * NTHREADS) ((u32x4*)(RS + M))[i] = (u32x4){0u, 0u, 0u, 0u};
            norm_phase(C, in_ptr(a, 0), XN, RS);
        } else {
            const int q = ph - 1, l = q / 9, s = q % 9;
            unsigned char* wb = ws + WS_W + (size_t)l * W_LSTRIDE;
            if (s == 0 || s == 7) {
                pg8::Gemm g{XN, (const bf16*)(wb + (s == 0 ? WO_1U : WO_2U)), M, NUP, D}; pg8::StaticOrder S; S.init(M, NUP, C.nblk, C.blk);
                pg8::EpiSwiglu E{HP, FF, RS + (size_t)(l * 3 + (s == 0 ? 0 : 2)) * M};
                for (int rep = 0; rep < DUPN(1); ++rep) { if (EN(2)) pg8::gemm_phase<pg8::EpiSwiglu, pg8::StaticOrder, true, true>(glds, g, S, E); }
            } else if (s == 1 || s == 8 || s == 6) {
                const bf16* A = (s == 6) ? YB : HP; const int K = (s == 6) ? D : FF;
                const bf16* Bt = (const bf16*)(wb + (s == 1 ? WO_1D : s == 6 ? WO_OUT : WO_2D));
                unsigned long long* rsn = (s == 1) ? RS + (size_t)(l * 3 + 1) * M : (s == 6) ? RS + (size_t)(l * 3 + 2) * M : (l + 1 < NLAYER) ? RS + (size_t)((l + 1) * 3) * M : nullptr;
                float* outf = (s == 8 && l + 1 == NLAYER) ? X : nullptr;
                pg8::Gemm g{A, Bt, M, D, K}; pg8::StaticOrder S; S.init(M, D, C.nblk, C.blk);
                pg8::EpiResid E{XN, outf, D, (s == 6) ? 1.0f : 0.5f, rsn};
                if (EN(3)) pg8::gemm_phase<pg8::EpiResid, pg8::StaticOrder, true, true>(glds, g, S, E);
            } else if (s == 2) {
                pg8::Gemm g{XN, (const bf16*)(wb + WO_IN), M, NPG, D}; pg8::StaticOrder S; S.init(M, NPG, C.nblk, C.blk);
                pg8::EpiRowScale E{HP, NP, RS + (size_t)(l * 3 + 1) * M};
                for (int rep = 0; rep < DUPN(2); ++rep) { if (EN(4)) pg8::gemm_phase<pg8::EpiRowScale, pg8::StaticOrder, true, true>(glds, g, S, E); }
                for (int u = C.blk * 8 + C.wave; u < M / 16; u += C.nblk * 8) small_gates_unit(C, XN, (const bf16*)(wb + WO_IN), RS + (size_t)(l * 3 + 1) * M, HP, u);
            } else if (s == 3) {
                const int vblk = (C.nblk % 8 == 0) ? (C.blk % 8) * (C.nblk / 8) + C.blk / 8 : C.blk;
                for (int u = vblk; u < 1024; u += C.nblk) {
                    if (u < 512) { if (EN(5)) REPT(5) gla_passA(C, HP, GST, GD, in_ptr(a, 7) + l * 16 * 256, in_ptr(a, 8) + l * 256, u); }
                    else if (EN(6)) REPT(6) ssd_passA(C, HP, XS, SST, SD, in_ptr(a, 14) + l * 4 * 768, in_ptr(a, 15) + l * 768, in_ptr(a, 16) + l * 4, in_ptr(a, 17) + l * 4, u - 512);
                }
                const int gw = C.blk * 8 + C.wave, NGW = C.nblk * 8;
                for (int u = gw; u < 2048; u += NGW) {
                    if (u < 1024) { if (EN(7)) REPT(7) sc_unit(C, HP, YB, in_ptr(a, 20) + l * 3 * 256, in_ptr(a, 21) + l * 256, u); }
                    else if (EN(8)) foxprep_unit(C, HP, VT, FRAW, in_ptr(a, 10) + l * 4, u - 1024);
                }
            } else if (s == 4) {
                if (EN(9)) scan_phase(C, GST, GD, GSB, SST, SD, SSB, FRAW, FL);
            } else {
                const int vblk = (C.nblk % 8 == 0) ? (C.blk % 8) * (C.nblk / 8) + C.blk / 8 : C.blk;
                const int nun = (1536 + C.nblk - 1 - vblk) / C.nblk, rot = (C.blk & 1) ? ((nun >= 3) ? nun / 3 : 0) : 0;
                for (int k_ = 0; k_ < nun; ++k_) { const int u = vblk + ((k_ + rot) % nun) * C.nblk;
                    if (u < 512) { if (EN(10)) REPT(10) fox_attn_unit(C, HP, VT, FL, YB, in_ptr(a, 11) + l * 64, in_ptr(a, 12) + l * 64, in_ptr(a, 13) + l * 256, u); }
                    else if (u < 1024) { if (EN(11)) REPT(11) ssd_passC(C, HP, XS, SSB, YB, in_ptr(a, 14) + l * 4 * 768, in_ptr(a, 15) + l * 768, in_ptr(a, 16) + l * 4, in_ptr(a, 17) + l * 4, in_ptr(a, 18) + l * 4, in_ptr(a, 19) + l * 256, u - 512); }
                    else if (EN(12)) REPT(12) gla_passC(C, HP, GSB, YB, in_ptr(a, 7) + l * 16 * 256, in_ptr(a, 8) + l * 256, in_ptr(a, 9) + l * 256, u - 1024);
                }
            }
        }
        if (ph + 1 < a.ph_hi) { xcd_barrier_flatrel(bar, nbar); if (DUPN(5) == 2) xcd_barrier_flatrel(bar, nbar); }
    }
}

extern "C" void kernel_launch(void* const* d_in, const int* in_sizes, int n_in, void* d_out, int out_size, void* d_ws, size_t ws_size, hipStream_t stream) {
    static int grid = 0;
    if (grid == 0) {
        if (n_in != 27 || out_size != M * D || ws_size < WS_END) { fprintf(stderr, "kernel_launch: unexpected shapes (n_in %d out %d ws %zu)\n", n_in, out_size, ws_size); grid = -1; return; }
        int dev = 0, cus = 0, per_cu = 0;
        (void)hipGetDevice(&dev); (void)hipDeviceGetAttribute(&cus, hipDeviceAttributeMultiprocessorCount, dev);
        (void)hipFuncSetAttribute((const void*)mega, hipFuncAttributeMaxDynamicSharedMemorySize, LDS_BYTES);
        (void)hipOccupancyMaxActiveBlocksPerMultiprocessor(&per_cu, (const void*)mega, NTHREADS, LDS_BYTES);
        if (per_cu < 1) per_cu = 1;
        (void)hipGetLastError();
        grid = cus * per_cu;
    }
    if (grid < 0) return;
    Args a{};
    for (int i = 0; i < 27; ++i) a.in[i] = (const float*)d_in[i];
    a.out = (float*)d_out; a.ws = (unsigned char*)d_ws;
#if MK_PER_PHASE
    for (int ph = 0; ph < NPHASE; ++ph) { a.ph_lo = ph; a.ph_hi = ph + 1; hipLaunchKernelGGL(mega, dim3(grid), dim3(NTHREADS), LDS_BYTES, stream, a); }
#else
    a.ph_lo = 0; a.ph_hi = NPHASE;
    (void)hipMemsetAsync(d_ws, 0, 16384, stream);
    void* args[] = {&a};
    hipError_t e = hipLaunchCooperativeKernel((const void*)mega, dim3(grid), dim3(NTHREADS), args, LDS_BYTES, stream);
    if (e != hipSuccess) fprintf(stderr, "cooperative launch failed: %s (grid %d)\n", hipGetErrorString(e), grid);
#endif
}
```
